# Optimizing an MI355X kernel written in HIP

```python
import math
import jax, jax.numpy as jnp
from jax import lax
import numpy as np

D_MODEL = 2048
BATCH = 16
SEQ = 256
DEPTH = 1
DEC_BATCH = 8
DEC_SEQ = 2048
PAST_LEN = 256

GRID_W = 64
MLA_HEADS = 8
QK_NOPE = 128
QK_ROPE = 64
V_HEAD = 128
Q_LORA = 512
KV_LORA = 256
MLA_WIDTH = MLA_HEADS * V_HEAD
ROPE_AXIS_FREQS = QK_ROPE // 4
ROPE_THETA = 10000.0
Q_BLOCK = 128
RWKV_HEADS = 16
RWKV_HEAD = 64
RWKV_WIDTH = RWKV_HEADS * RWKV_HEAD
DECAY_LORA = 64
ICLR_LORA = 64
GATE_LORA = 128
MIX_WIDTH = MLA_WIDTH + RWKV_WIDTH
OFF_KV = Q_LORA
OFF_KR = OFF_KV + KV_LORA
OFF_RW = OFF_KR + QK_ROPE
RW_COLS = 3 * RWKV_WIDTH + DECAY_LORA + ICLR_LORA + GATE_LORA
IN_COLS = OFF_RW + RW_COLS
D_FF = ((8 * D_MODEL + 3 * 256 - 1) // (3 * 256)) * 256
LN_EPS = 1e-5
RMS_EPS = 1e-6
GN_EPS = 64e-5
ALPHA = (2.0 * DEPTH) ** 0.25
BETA = (8.0 * DEPTH) ** -0.25

kernel_name = "hymba_mla_rwkv7_flow_step"

F32 = jnp.float32


def _layer_norm(x, g, b):
    xf = x.astype(F32)
    mu = jnp.mean(xf, -1, keepdims=True)
    var = jnp.mean(jnp.square(xf - mu), -1, keepdims=True)
    return ((xf - mu) * lax.rsqrt(var + LN_EPS) * g + b).astype(x.dtype)


def _rms_norm(x, g):
    xf = x.astype(F32)
    return (xf * lax.rsqrt(jnp.mean(xf * xf, -1, keepdims=True) + RMS_EPS) * g).astype(x.dtype)


def _adaln(cond, w_mod, b_mod):
    m = jax.nn.silu(cond) @ w_mod + b_mod
    return jnp.split(m[:, None, :], 6, axis=-1)


def _post_norm(x, gate, f, g, b):
    return _layer_norm(ALPHA * x + gate * f, g, b)


def _axial_rope_angles(n_tokens):
    rows = n_tokens // GRID_W
    row = jnp.repeat(jnp.arange(rows), GRID_W).astype(F32)
    col = jnp.tile(jnp.arange(GRID_W), rows).astype(F32)
    freqs = ROPE_THETA ** (-jnp.arange(ROPE_AXIS_FREQS, dtype=F32) / ROPE_AXIS_FREQS)
    ang = jnp.concatenate([row[:, None] * freqs, col[:, None] * freqs], -1)
    return jnp.cos(ang), jnp.sin(ang)


def _apply_rope(x, cos, sin):
    half = QK_ROPE // 2
    x1, x2 = x[..., :half].astype(F32), x[..., half:].astype(F32)
    return jnp.concatenate([x1 * cos - x2 * sin, x2 * cos + x1 * sin], -1).astype(x.dtype)


def _mla_queries(q_down, p):
    b, n, _ = q_down.shape
    q = (_rms_norm(q_down, p["q_norm_g"]) @ p["w_uq"]).reshape(b, n, MLA_HEADS, QK_NOPE + QK_ROPE)
    return q[..., :QK_NOPE], q[..., QK_NOPE:]


def _mla_kv(ckv, p):
    b, n, _ = ckv.shape
    k_nope = (ckv @ p["w_uk"]).reshape(b, n, MLA_HEADS, QK_NOPE)
    v = (ckv @ p["w_uv"]).reshape(b, n, MLA_HEADS, V_HEAD)
    return k_nope, v


def _attend(q_nope, q_rope, k_nope, k_rope, v):
    scale = 1.0 / math.sqrt(QK_NOPE + QK_ROPE)
    s = jnp.einsum("bqhd,bkhd->bhqk", q_nope, k_nope) + jnp.einsum("bqhd,bkd->bhqk", q_rope, k_rope)
    pr = jax.nn.softmax(s.astype(F32) * scale, axis=-1).astype(v.dtype)
    return jnp.einsum("bhqk,bkhd->bqhd", pr, v)


def _attend_blocked(q_nope, q_rope, k_nope, k_rope, v):
    b, n, h, _ = q_nope.shape
    nb = n // Q_BLOCK
    to_blocks = lambda t: jnp.moveaxis(t.reshape(b, nb, Q_BLOCK, *t.shape[2:]), 1, 0)
    out = lax.map(lambda qs: _attend(qs[0], qs[1], k_nope, k_rope, v), (to_blocks(q_nope), to_blocks(q_rope)))
    return jnp.moveaxis(out, 0, 1).reshape(b, n, h, V_HEAD)


def _centred_shift(u, mu):
    prev = jnp.pad(u[:, :-1], ((0, 0), (1, 0), (0, 0)))
    nxt = jnp.pad(u[:, 1:], ((0, 0), (0, 1), (0, 0)))
    return u + mu * (0.5 * (prev + nxt) - u)


def _wkv_scan(s0, r, decay, k, v, kk, a, reverse):
    to_t = lambda t: jnp.moveaxis(t.astype(F32), 1, 0)

    def step(S, inp):
        r_t, w_t, k_t, v_t, kk_t, a_t = inp
        sa = jnp.einsum("bhvk,bhk->bhv", S, -kk_t)
        S = S * w_t[:, :, None, :] + sa[..., None] * (kk_t * a_t)[:, :, None, :] + v_t[..., None] * k_t[:, :, None, :]
        return S, jnp.einsum("bhvk,bhk->bhv", S, r_t)

    s_fin, ys = lax.scan(step, s0.astype(F32), (to_t(r), to_t(decay), to_t(k), to_t(v), to_t(kk), to_t(a)), reverse=reverse)
    return s_fin, jnp.moveaxis(ys, 0, 1)


def _rwkv_mixer(u, s0_fwd, s0_bwd, p):
    b, n, _ = u.shape
    u = _centred_shift(u, p["tok_shift_mu"])
    W = RWKV_WIDTH
    r, k, v = u[..., :W], u[..., W:2 * W], u[..., 2 * W:3 * W]
    wd = u[..., 3 * W:3 * W + DECAY_LORA]
    ad = u[..., 3 * W + DECAY_LORA:3 * W + DECAY_LORA + ICLR_LORA]
    gd = u[..., 3 * W + DECAY_LORA + ICLR_LORA:]
    heads = lambda t: t.reshape(b, n, RWKV_HEADS, RWKV_HEAD)
    kk = heads(k * p["k_k"]).astype(F32)
    kk = kk * lax.rsqrt(jnp.maximum(jnp.sum(kk * kk, -1, keepdims=True), 1e-24))
    g = jax.nn.sigmoid(gd) @ p["g_up"]
    r_h, v_h = heads(r), heads(v)
    r_k = p["r_k"].reshape(RWKV_HEADS, RWKV_HEAD)
    ys, bonuses, states = [], [], []
    for w0, w_up, a0, a_up, s0, rev in ((p["w0_fwd"], p["w_up_fwd"], p["a0_fwd"], p["a_up_fwd"], s0_fwd, False),
                                       (p["w0_bwd"], p["w_up_bwd"], p["a0_bwd"], p["a_up_bwd"], s0_bwd, True)):
        logw = -jax.nn.softplus(-(w0 + jnp.tanh(wd) @ w_up).astype(F32)) - 0.5
        decay = jnp.exp(-jnp.exp(logw))
        a = jax.nn.sigmoid(a0 + ad @ a_up)
        k_dir = heads(k * (1 + (a - 1) * p["k_a"]))
        s_fin, y_dir = _wkv_scan(s0, r_h, heads(decay), k_dir, v_h, kk, heads(a), rev)
        ys.append(y_dir)
        states.append(s_fin)
        bonuses.append(jnp.sum((r_h * k_dir * r_k).astype(F32), -1, keepdims=True) * v_h.astype(F32))
    y = ys[0] + ys[1]
    mu = jnp.mean(y, -1, keepdims=True)
    var = jnp.mean(jnp.square(y - mu), -1, keepdims=True)
    y = ((y - mu) * lax.rsqrt(var + GN_EPS)).reshape(b, n, W) * p["gn_g"] + p["gn_b"]
    y = (y + (bonuses[0] + bonuses[1]).reshape(b, n, W)) * g
    return y.astype(u.dtype), states[0], states[1]


def _merge(att, rw, p):
    b, n = rw.shape[:2]
    return jnp.concatenate([att.reshape(b, n, MLA_WIDTH), rw], -1) @ p["w_out"]


def _swiglu(h, p):
    return (jax.nn.silu(h @ p["w_ffn_gate"]) * (h @ p["w_ffn_up"])) @ p["w_ffn_down"]


def _context_layer(x, c_ctx, p):
    b, n, _ = x.shape
    sh1, sc1, g1, sh2, sc2, g2 = _adaln(c_ctx[None, :], p["w_mod"], p["b_mod"])
    proj = (x * (1 + sc1) + sh1) @ p["w_in"]
    q_nope, q_rope = _mla_queries(proj[..., :OFF_KV], p)
    ckv = _rms_norm(proj[..., OFF_KV:OFF_KR], p["kv_norm_g"])
    k_rope = proj[..., OFF_KR:OFF_RW]
    k_nope, v = _mla_kv(ckv, p)
    att = _attend(q_nope, q_rope, k_nope, k_rope, v)
    zeros = jnp.zeros((b, RWKV_HEADS, RWKV_HEAD, RWKV_HEAD), F32)
    rw, s_fwd, s_bwd = _rwkv_mixer(proj[..., OFF_RW:], zeros, zeros, p)
    x = _post_norm(x, g1, _merge(att, rw, p), p["ln1_g"], p["ln1_b"])
    x = _post_norm(x, g2, _swiglu(x * (1 + sc2) + sh2, p), p["ln2_g"], p["ln2_b"])
    return x, ckv, k_rope, s_fwd, s_bwd


def _latent_layer(x, c, ckv_ctx, krope_ctx, s_fwd, s_bwd, p):
    b, n, _ = x.shape
    sh1, sc1, g1, sh2, sc2, g2 = _adaln(c, p["w_mod"], p["b_mod"])
    proj = (x * (1 + sc1) + sh1) @ p["w_in"]
    cos, sin = _axial_rope_angles(n)
    q_nope, q_rope = _mla_queries(proj[..., :OFF_KV], p)
    q_rope = _apply_rope(q_rope, cos[:, None, :], sin[:, None, :])
    ckv = _rms_norm(proj[..., OFF_KV:OFF_KR], p["kv_norm_g"])
    k_rope = _apply_rope(proj[..., OFF_KR:OFF_RW], cos, sin)
    k_nope, v = _mla_kv(ckv, p)
    k_nope_c, v_c = _mla_kv(ckv_ctx, p)
    att = _attend_blocked(q_nope, q_rope,
                          jnp.concatenate([k_nope, k_nope_c], 1),
                          jnp.concatenate([k_rope, krope_ctx.astype(k_rope.dtype)], 1),
                          jnp.concatenate([v, v_c], 1))
    rw, _, _ = _rwkv_mixer(proj[..., OFF_RW:], s_fwd, s_bwd, p)
    x = _post_norm(x, g1, _merge(att, rw, p), p["ln1_g"], p["ln1_b"])
    x = _post_norm(x, g2, _swiglu(x * (1 + sc2) + sh2, p), p["ln2_g"], p["ln2_b"])
    return x


def setup_inputs(seed: int = 0) -> dict:
    key = jax.random.key(seed)
    ks = iter(jax.random.split(key, 48))
    nrm = lambda shape, scale: jax.random.normal(next(ks), shape, F32) * scale
    uni = lambda shape, lo, hi: jax.random.uniform(next(ks), shape, F32, lo, hi)
    L = DEPTH
    return {
        "x_prompt": nrm((BATCH, SEQ, D_MODEL), 1.0),
        "x_sample": nrm((DEC_BATCH, DEC_SEQ, D_MODEL), 1.0),
        "cache_ckv": nrm((DEC_BATCH, L, PAST_LEN, KV_LORA), 1.0),
        "cache_krope": nrm((DEC_BATCH, L, PAST_LEN, QK_ROPE), 1.0),
        "state_wkv_fwd": nrm((DEC_BATCH, L, RWKV_HEADS, RWKV_HEAD, RWKV_HEAD), 0.5),
        "state_wkv_bwd": nrm((DEC_BATCH, L, RWKV_HEADS, RWKV_HEAD, RWKV_HEAD), 0.5),
        "c": nrm((DEC_BATCH, D_MODEL), 1.0),
        "c_ctx": nrm((D_MODEL,), 1.0),
        "w_mod": nrm((L, D_MODEL, 6 * D_MODEL), 0.5 * D_MODEL ** -0.5),
        "b_mod": nrm((L, 6 * D_MODEL), 0.02),
        "w_in": nrm((L, D_MODEL, IN_COLS), D_MODEL ** -0.5),
        "q_norm_g": 1.0 + nrm((L, Q_LORA), 0.1),
        "kv_norm_g": 1.0 + nrm((L, KV_LORA), 0.1),
        "w_uq": nrm((L, Q_LORA, MLA_HEADS * (QK_NOPE + QK_ROPE)), Q_LORA ** -0.5),
        "w_uk": nrm((L, KV_LORA, MLA_HEADS * QK_NOPE), KV_LORA ** -0.5),
        "w_uv": nrm((L, KV_LORA, MLA_HEADS * V_HEAD), KV_LORA ** -0.5),
        "tok_shift_mu": uni((L, RW_COLS), 0.0, 1.0),
        "w0_fwd": uni((L, RWKV_WIDTH), -4.0, 1.0),
        "w_up_fwd": nrm((L, DECAY_LORA, RWKV_WIDTH), 0.5 * DECAY_LORA ** -0.5),
        "a0_fwd": nrm((L, RWKV_WIDTH), 0.1),
        "a_up_fwd": nrm((L, ICLR_LORA, RWKV_WIDTH), 0.5 * ICLR_LORA ** -0.5),
        "w0_bwd": uni((L, RWKV_WIDTH), -4.0, 1.0),
        "w_up_bwd": nrm((L, DECAY_LORA, RWKV_WIDTH), 0.5 * DECAY_LORA ** -0.5),
        "a0_bwd": nrm((L, RWKV_WIDTH), 0.1),
        "a_up_bwd": nrm((L, ICLR_LORA, RWKV_WIDTH), 0.5 * ICLR_LORA ** -0.5),
        "g_up": nrm((L, GATE_LORA, RWKV_WIDTH), GATE_LORA ** -0.5),
        "k_k": 0.85 + nrm((L, RWKV_WIDTH), 0.05),
        "k_a": 1.0 + nrm((L, RWKV_WIDTH), 0.05),
        "r_k": nrm((L, RWKV_WIDTH), 0.1),
        "gn_g": 1.0 + nrm((L, RWKV_WIDTH), 0.1),
        "gn_b": nrm((L, RWKV_WIDTH), 0.02),
        "w_out": nrm((L, MIX_WIDTH, D_MODEL), BETA * MIX_WIDTH ** -0.5),
        "ln1_g": 1.0 + nrm((L, D_MODEL), 0.1),
        "ln1_b": nrm((L, D_MODEL), 0.02),
        "w_ffn_gate": nrm((L, D_MODEL, D_FF), D_MODEL ** -0.5),
        "w_ffn_up": nrm((L, D_MODEL, D_FF), D_MODEL ** -0.5),
        "w_ffn_down": nrm((L, D_FF, D_MODEL), BETA * D_FF ** -0.5),
        "ln2_g": 1.0 + nrm((L, D_MODEL), 0.1),
        "ln2_b": nrm((L, D_MODEL), 0.02),
    }


def reference(x_prompt, x_sample, cache_ckv, cache_krope, state_wkv_fwd, state_wkv_bwd, c, c_ctx,
              w_mod, b_mod, w_in, q_norm_g, kv_norm_g, w_uq, w_uk, w_uv, tok_shift_mu,
              w0_fwd, w_up_fwd, a0_fwd, a_up_fwd, w0_bwd, w_up_bwd, a0_bwd, a_up_bwd,
              g_up, k_k, k_a, r_k, gn_g, gn_b, w_out, ln1_g, ln1_b,
              w_ffn_gate, w_ffn_up, w_ffn_down, ln2_g, ln2_b):
    weights = dict(w_mod=w_mod, b_mod=b_mod, w_in=w_in, q_norm_g=q_norm_g, kv_norm_g=kv_norm_g,
                   w_uq=w_uq, w_uk=w_uk, w_uv=w_uv, tok_shift_mu=tok_shift_mu,
                   w0_fwd=w0_fwd, w_up_fwd=w_up_fwd, a0_fwd=a0_fwd, a_up_fwd=a_up_fwd,
                   w0_bwd=w0_bwd, w_up_bwd=w_up_bwd, a0_bwd=a0_bwd, a_up_bwd=a_up_bwd,
                   g_up=g_up, k_k=k_k, k_a=k_a, r_k=r_k, gn_g=gn_g, gn_b=gn_b, w_out=w_out,
                   ln1_g=ln1_g, ln1_b=ln1_b, w_ffn_gate=w_ffn_gate, w_ffn_up=w_ffn_up,
                   w_ffn_down=w_ffn_down, ln2_g=ln2_g, ln2_b=ln2_b)
    y_prompt, y_sample = x_prompt, x_sample
    ckv_list, krope_list, sf_list, sb_list = [], [], [], []
    for l in range(DEPTH):
        p = {name: arr[l] for name, arr in weights.items()}
        y_prompt, ckv, krope, s_f, s_b = _context_layer(y_prompt, c_ctx, p)
        ckv_list.append(ckv)
        krope_list.append(krope)
        sf_list.append(s_f)
        sb_list.append(s_b)
        y_sample = _latent_layer(y_sample, c, cache_ckv[:, l], cache_krope[:, l],
                                 state_wkv_fwd[:, l], state_wkv_bwd[:, l], p)
    new_ckv = jnp.stack(ckv_list, 1)
    new_krope = jnp.stack(krope_list, 1)
    new_state_fwd = jnp.stack(sf_list, 1)
    new_state_bwd = jnp.stack(sb_list, 1)
    return (y_prompt, y_sample, new_ckv, new_krope, new_state_fwd, new_state_bwd)
```

```cpp
#include <hip/hip_runtime.h>
#include <hip/hip_cooperative_groups.h>
#include <cstdio>
#include <cstdint>
namespace cg = cooperative_groups;
#ifndef PHM
#define PHM 0x3fff
#endif
#ifndef REPM
#define REPM 0
#endif

#define LAS __attribute__((address_space(3)))
typedef unsigned short bf16_t;
typedef short bf16x8 __attribute__((ext_vector_type(8)));
typedef short s16x4 __attribute__((ext_vector_type(4)));
typedef float f32x4 __attribute__((ext_vector_type(4)));
typedef float f32x2 __attribute__((ext_vector_type(2)));
typedef float f32x16 __attribute__((ext_vector_type(16)));
typedef unsigned u32x4 __attribute__((ext_vector_type(4)));
typedef unsigned u32x2 __attribute__((ext_vector_type(2)));

constexpr int DM = 2048, TP = 4096, TS = 16384, T = TP + TS;
constexpr int KVROWS = TP + 8 * 2304;
constexpr int INC = 4160, INP = 4352;
constexpr int DFF = 5632;
constexpr float ALPHA = 1.189207115002721f;
constexpr float LN_EPS = 1e-5f, RMS_EPS = 1e-6f, GN_EPS = 64e-5f;

constexpr size_t al256(size_t x) { return (x + 255) / 256 * 256; }
constexpr size_t PADU = 256 * 37;
constexpr int XCD_BAR_WORDS_C = 3456;
constexpr size_t O_WIN = 0;
constexpr size_t O_WUQ = O_WIN + al256((size_t)INP * 2048 * 2);
constexpr size_t O_WKV = O_WUQ + al256((size_t)1536 * 512 * 2);
constexpr size_t O_WLO = O_WKV + al256((size_t)2048 * 256 * 2);
constexpr size_t O_WOUT = O_WLO + al256((size_t)5120 * 256 * 2);
constexpr size_t O_MOD = O_WOUT + al256((size_t)2048 * 2048 * 2);
constexpr size_t O_BAR = O_MOD + al256((size_t)9 * 12288 * 4);
constexpr size_t O_RK = O_BAR + al256((size_t)XCD_BAR_WORDS_C * 4);
constexpr size_t O_ROPE = O_RK + al256((size_t)T * 16 * 4);
constexpr size_t O_RF = O_ROPE + al256((size_t)2 * 2048 * 32 * 4);
constexpr size_t O_WGU = O_RF;
constexpr size_t O_WDN = O_WGU + al256((size_t)11264 * 2048 * 2);
constexpr size_t O_R1 = O_WDN + al256((size_t)2048 * 5632 * 2);
constexpr size_t O_XM = O_R1;
constexpr size_t O_QN = O_R1;
constexpr size_t O_CKV = O_QN + al256((size_t)T * 512 * 2);
constexpr size_t O_KR = O_CKV + al256((size_t)KVROWS * 256 * 2);
constexpr size_t O_LIN = O_KR + al256((size_t)KVROWS * 64 * 2);
constexpr size_t O_R2 = O_R1 + al256((size_t)T * 2048 * 2);
constexpr size_t O_PROJ = O_R2;
constexpr size_t O_A = O_R2;
constexpr size_t ADS = (size_t)T * 1024 + PADU / 2;
constexpr size_t O_G = O_A + 2 * ADS * 2 + 3 * PADU;
constexpr size_t O_YB = O_G + (size_t)T * 1024 * 2 + 5 * PADU;
constexpr size_t O_KVB = O_R2;
constexpr size_t O_Q = O_KVB + al256((size_t)KVROWS * 2048 * 2);
constexpr size_t O_H1 = O_R2;
constexpr size_t O_ACT = O_R2;
constexpr size_t O_R3 = O_R2 + al256((size_t)T * INC * 2);
constexpr size_t O_PART = O_ACT + al256((size_t)T * DFF * 2);
constexpr size_t O_R = O_R3;
constexpr size_t O_K = O_R + (size_t)T * 1024 * 2 + 7 * PADU;
constexpr size_t O_V = O_K + (size_t)T * 1024 * 2 + 11 * PADU;
constexpr size_t O_YF = O_R3 + al256((size_t)3 * T * 1024 * 2 + 32 * PADU) + 13 * PADU;
constexpr size_t O_BON = O_YF + al256((size_t)T * 1024 * 2) + PADU;
constexpr size_t WS_END = O_BON + al256((size_t)2 * T * 16 * 4);
static_assert(O_YB + (size_t)T * 1024 * 2 <= O_R3, "R2 overflow (a,g,yb)");
static_assert(O_Q + (size_t)T * 1536 * 2 <= O_R3, "R2 overflow (kv,q)");
static_assert(O_ACT + (size_t)T * DFF * 2 <= WS_END, "act overflow");
static_assert(O_LIN + (size_t)T * 256 * 2 <= O_R2, "R1 overflow");
constexpr size_t OUT_CKV = (size_t)T * 2048, OUT_KR = OUT_CKV + 16 * 256 * 256, OUT_SF = OUT_KR + 16 * 256 * 64, OUT_SB = OUT_SF + 16 * 16 * 4096;

struct Params {
    const float *x_prompt, *x_sample, *cache_ckv, *cache_krope, *st_f, *st_b, *c, *c_ctx, *w_mod, *b_mod, *w_in, *q_norm_g, *kv_norm_g, *w_uq, *w_uk, *w_uv,
        *tok_mu, *w0_f, *w_up_f, *a0_f, *a_up_f, *w0_b, *w_up_b, *a0_b, *a_up_b, *g_up, *k_k, *k_a, *r_k, *gn_g, *gn_b, *w_out, *ln1_g, *ln1_b, *w_gate, *w_up,
        *w_down, *ln2_g, *ln2_b;
    float* out; char* ws;
    int phase_lo, phase_hi;
};

__device__ __forceinline__ float bf2f(bf16_t v) { return __uint_as_float(((unsigned)v) << 16); }
__device__ __forceinline__ bf16_t f2bf(float f) { unsigned u = __float_as_uint(f); u += 0x7FFFu + ((u >> 16) & 1u); return (bf16_t)(u >> 16); }
__device__ __forceinline__ unsigned cvtpk(float lo, float hi) { unsigned r; asm volatile("v_cvt_pk_bf16_f32 %0, %1, %2" : "=v"(r) : "v"(lo), "v"(hi)); return r; }
__device__ __forceinline__ void unpack8(u32x4 w, float (&f)[8]) {
#pragma unroll
    for (int i = 0; i < 4; ++i) { f[2 * i] = __uint_as_float(w[i] << 16); f[2 * i + 1] = __uint_as_float(w[i] & 0xffff0000u); }
}
__device__ __forceinline__ u32x4 pack8(const float (&f)[8]) { u32x4 w = {cvtpk(f[0], f[1]), cvtpk(f[2], f[3]), cvtpk(f[4], f[5]), cvtpk(f[6], f[7])}; return w; }
__device__ __forceinline__ u32x4 ldnt(const void* p) { return __builtin_nontemporal_load((const u32x4*)p); }
__device__ __forceinline__ f32x4 ldntf(const float* p) { return __builtin_nontemporal_load((const f32x4*)p); }
__device__ __forceinline__ void stntf(float* p, f32x4 v) { __builtin_nontemporal_store(v, (f32x4*)p); }
__device__ __forceinline__ float sigmoidf_(float x) { float r = __builtin_amdgcn_rcpf(1.f + __expf(-x)); asm volatile("s_nop 1" : "+v"(r)); return r; }
__device__ __forceinline__ const float* xrow(const Params& p, int row) { return row < TP ? p.x_prompt + (size_t)row * DM : p.x_sample + (size_t)(row - TP) * DM; }
__device__ __forceinline__ int cond_of(int row) { return row < TP ? 0 : 1 + ((row - TP) >> 11); }
__device__ __forceinline__ int kvrow_of(int row) { return row < TP ? row : TP + ((row - TP) >> 11) * 2304 + ((row - TP) & 2047); }

namespace pg8 {
constexpr int BM = 256, BK = 64, HALF = 128, HTB = HALF * BK * 2, STAGE_BYTES = 8 * HTB, NXCD = 8, WGM = 2;
__host__ __device__ __forceinline__ int lds_byte(int r, int c) { const int st = (r >> 4) * 2 + (c >> 5), rr = r & 15, cc = c & 31, ob = rr * 64 + cc * 2; return st * 1024 + (ob ^ (((ob >> 9) & 1) << 5)); }
__host__ __device__ __forceinline__ void stage_rc(int b, int& R, int& C) { const int st = b / 1024, sb = b % 1024, swz = sb ^ (((sb >> 9) & 1) << 5); R = (st >> 1) * 16 + swz / 64; C = (st & 1) * 32 + (swz % 64) / 2; }
struct Unit { int pm, pn; };
struct Gemm { const bf16_t* A; const bf16_t* Bt; int M, N, K; int nNr = 0; };
struct StaticOrder {
    int nM, nN, nwg, G, c, split_from;
    __device__ void init(int M, int N, int G_, int c_) { nM = M / BM; nN = N / BM; nwg = nM * nN; G = G_; c = c_; split_from = 0x7fffffff; }
    __device__ bool next(int i, Unit& u) const {
        long L = (long)i * G + c; int kh = 0;
        if (L >= split_from) { const long h = L - split_from; L = split_from + (h >> 1); kh = 1 + (int)(h & 1); }
        if (L >= nwg) return false;
        int wgid = (int)L; { const int q = nwg / NXCD, r = nwg % NXCD, xcd = wgid % NXCD, off = wgid / NXCD; wgid = (xcd < r ? xcd * (q + 1) : r * (q + 1) + (xcd - r) * q) + off; }
        const int nig = WGM * nN, gid = wgid / nig, fm = gid * WGM, gsz = (nM - fm) < WGM ? (nM - fm) : WGM;
        u.pm = fm + ((wgid % nig) % gsz); u.pn = (wgid % nig) / gsz + kh * nN; return true;
    }
};
template <class Epi>
__device__ __forceinline__ void gemm_phase(LAS unsigned char* lds, const Gemm g, const StaticOrder& S, const Epi& E) {
    const int tid = threadIdx.x, wid = __builtin_amdgcn_readfirstlane(tid >> 6), lane = tid & 63, wr = wid >> 2, wc = wid & 3, fr = lane & 15, fq = lane >> 4;
    int K_ = g.K; asm volatile("" : "+s"(K_));
    const int K = K_, nt = K / BK, nNr = g.nNr;
    const size_t khalf = (size_t)K;
#define PG8_KH(u) (nNr ? (u).pn / nNr : 0)
#define PG8_UA(u) ((const char*)g.A + (size_t)(u).pm * tstep + (PG8_KH(u) == 2 ? khalf : (size_t)0))
#define PG8_UB(u) ((const char*)g.Bt + (size_t)((u).pn - PG8_KH(u) * nNr) * tstep + (PG8_KH(u) == 2 ? khalf : (size_t)0))
#define PG8_NT(u) (PG8_KH(u) ? nt / 2 : nt)
    unsigned voffA[2], voffB[2];
#pragma unroll
    for (int i = 0; i < 2; ++i) { int R, C; stage_rc(tid * 16 + i * 8192, R, C); voffA[i] = (unsigned)(R * K + C) * 2u; voffB[i] = voffA[i]; }
    const size_t kstep = (size_t)(BK * 2);
    const size_t hstep = (size_t)HALF * K * 2;
    const size_t tstep = 2 * hstep;
    const unsigned ldsw = (unsigned)wid * 1024u;
    const int aoff = lds_byte(wr * 64 + fr, fq * 8), boff = lds_byte(wc * 32 + fr, fq * 8);
#define PG8_SA(b, h) (((b) * 2 + (h)) * HTB)
#define PG8_SB(b, h) ((4 + (b) * 2 + (h)) * HTB)
#define PG8_STAGE(bufoff, gbase, voff) do { _Pragma("unroll") for (int _i = 0; _i < 2; ++_i) \
        __builtin_amdgcn_global_load_lds((const unsigned*)((const char*)(gbase) + (voff)[_i]), (LAS unsigned*)(lds + (bufoff) + ldsw + _i * 8192), 16, 0, 0); } while (0)
#define PG8_LDA(dst, b, h) do { _Pragma("unroll") for (int m = 0; m < 4; ++m) _Pragma("unroll") for (int k = 0; k < 2; ++k) dst[m][k] = *(const LAS bf16x8*)(lds + PG8_SA(b, h) + aoff + m * 2048 + k * 1024); } while (0)
#define PG8_LDB(dst, b, h) do { _Pragma("unroll") for (int n = 0; n < 2; ++n) _Pragma("unroll") for (int k = 0; k < 2; ++k) dst[n][k] = *(const LAS bf16x8*)(lds + PG8_SB(b, h) + boff + n * 2048 + k * 1024); } while (0)
#define PG8_MMA(ai, bj, At, Bt) do { __builtin_amdgcn_s_setprio(1); _Pragma("unroll") for (int m = 0; m < 4; ++m) _Pragma("unroll") for (int n = 0; n < 2; ++n) _Pragma("unroll") for (int k = 0; k < 2; ++k) \
        acc[ai][bj][m][n] = __builtin_amdgcn_mfma_f32_16x16x32_bf16(Bt[n][k], At[m][k], acc[ai][bj][m][n], 0, 0, 0); __builtin_amdgcn_s_setprio(0); } while (0)
#define PG8_WAIT_V(n) asm volatile("s_waitcnt vmcnt(" #n ")" ::: "memory")
#define PG8_WAIT_L(n) asm volatile("s_waitcnt lgkmcnt(" #n ")" ::: "memory")
#define PG8_BAR __builtin_amdgcn_s_barrier()
#define PG8_SCHED __builtin_amdgcn_sched_barrier(0)
    Unit cur, nxt; int ui = 0;
    if (!S.next(0, cur)) return;
    f32x4 acc[2][2][4][2];
#pragma unroll
    for (int a = 0; a < 2; ++a)
#pragma unroll
        for (int b = 0; b < 2; ++b)
#pragma unroll
            for (int m = 0; m < 4; ++m)
#pragma unroll
                for (int n = 0; n < 2; ++n) acc[a][b][m][n] = (f32x4){0.f, 0.f, 0.f, 0.f};
    bf16x8 At[4][2], B0[2][2], B1[2][2];
    const char* cA = PG8_UA(cur); const char* cB = PG8_UB(cur); int cnt = PG8_NT(cur);
    PG8_STAGE(PG8_SB(0, 0), cB, voffB); PG8_STAGE(PG8_SA(0, 0), cA, voffA); PG8_STAGE(PG8_SB(0, 1), cB + hstep, voffB); PG8_STAGE(PG8_SA(0, 1), cA + hstep, voffA);
    if (wr == 1) PG8_BAR;
    PG8_WAIT_V(4); PG8_BAR;
    PG8_STAGE(PG8_SB(1, 0), cB + kstep, voffB); PG8_STAGE(PG8_SA(1, 0), cA + kstep, voffA); PG8_STAGE(PG8_SB(1, 1), cB + hstep + kstep, voffB);
    PG8_WAIT_V(6); PG8_BAR;
    for (;;) {
        const bool has_next = S.next(ui + 1, nxt);
        const char* nA = has_next ? PG8_UA(nxt) : cA; const char* nB = has_next ? PG8_UB(nxt) : cB;
        for (int t = 0; t < cnt; t += 2) {
            const bool last = (t == cnt - 2);
            const char* a1 = cA + (size_t)(t + 1) * kstep;
            const char* a2 = last ? nA : cA + (size_t)(t + 2) * kstep; const char* b2 = last ? nB : cB + (size_t)(t + 2) * kstep;
            const char* a3 = a2 + kstep; const char* b3 = b2 + kstep;
            PG8_LDB(B0, 0, 0); PG8_SCHED; PG8_LDA(At, 0, 0); PG8_STAGE(PG8_SA(1, 1), a1 + hstep, voffA);
            PG8_WAIT_L(8); PG8_BAR; PG8_WAIT_L(0); PG8_MMA(0, 0, At, B0); PG8_BAR; PG8_SCHED;
            PG8_LDB(B1, 0, 1); PG8_STAGE(PG8_SB(0, 0), b2, voffB);
            PG8_BAR; PG8_WAIT_L(0); PG8_MMA(0, 1, At, B1); PG8_BAR;
            PG8_LDA(At, 0, 1); PG8_STAGE(PG8_SA(0, 0), a2, voffA);
            PG8_BAR; PG8_WAIT_L(0); PG8_MMA(1, 0, At, B0); PG8_BAR; PG8_SCHED;
            PG8_STAGE(PG8_SB(0, 1), b2 + hstep, voffB);
            PG8_WAIT_V(6); PG8_BAR; PG8_MMA(1, 1, At, B1); PG8_BAR;
            PG8_LDB(B0, 1, 0); PG8_SCHED; PG8_LDA(At, 1, 0); PG8_STAGE(PG8_SA(0, 1), a2 + hstep, voffA);
            PG8_WAIT_L(8); PG8_BAR; PG8_WAIT_L(0); PG8_MMA(0, 0, At, B0); PG8_BAR; PG8_SCHED;
            PG8_LDB(B1, 1, 1); PG8_STAGE(PG8_SB(1, 0), b3, voffB);
            PG8_BAR; PG8_WAIT_L(0); PG8_MMA(0, 1, At, B1); PG8_BAR;
            PG8_LDA(At, 1, 1); PG8_STAGE(PG8_SA(1, 0), a3, voffA);
            PG8_BAR; PG8_WAIT_L(0); PG8_MMA(1, 0, At, B0); PG8_BAR; PG8_SCHED;
            PG8_STAGE(PG8_SB(1, 1), b3 + hstep, voffB);
            PG8_WAIT_V(6); PG8_BAR; PG8_MMA(1, 1, At, B1); PG8_BAR;
        }
        E(acc, cur, wr, wc, fr, fq);
        if (!has_next) break;
#pragma unroll
        for (int a = 0; a < 2; ++a)
#pragma unroll
            for (int b = 0; b < 2; ++b)
#pragma unroll
                for (int m = 0; m < 4; ++m)
#pragma unroll
                    for (int n = 0; n < 2; ++n) acc[a][b][m][n] = (f32x4){0.f, 0.f, 0.f, 0.f};
        cur = nxt; cA = nA; cB = nB; cnt = PG8_NT(cur); ++ui;
    }
    PG8_WAIT_V(0);
    if (wr == 0) PG8_BAR;
    PG8_BAR;
#undef PG8_KH
#undef PG8_UA
#undef PG8_UB
#undef PG8_NT
#undef PG8_SA
#undef PG8_SB
#undef PG8_STAGE
#undef PG8_LDA
#undef PG8_LDB
#undef PG8_MMA
#undef PG8_WAIT_V
#undef PG8_WAIT_L
#undef PG8_BAR
#undef PG8_SCHED
}
__device__ __forceinline__ int opaque_i(int v) { asm volatile("" : "+v"(v)); return v; }
template <class F> struct EpiEach {
    F f; bf16_t* out; int ld, ncols;
    __device__ __forceinline__ void operator()(const f32x4 (&acc)[2][2][4][2], const Unit& u, int wr, int wc, int fr, int fq) const {
        const int row0 = u.pm * BM + wr * 64 + fr, col0 = u.pn * BM + wc * 32 + 8 * fq;
#pragma unroll
        for (int ai = 0; ai < 2; ++ai)
#pragma unroll
            for (int m = 0; m < 4; ++m) { const int row = opaque_i(row0 + ai * HALF + m * 16);
#pragma unroll
                for (int bj = 0; bj < 2; ++bj) { const int col = col0 + bj * HALF;
                    if (col < ncols) { const f32x4 lo = f(row, col, acc[ai][bj][m][0]), hi = f(row, col + 4, acc[ai][bj][m][1]);
                        *(u32x4*)(out + (size_t)row * ld + col) = (u32x4){cvtpk(lo[0], lo[1]), cvtpk(lo[2], lo[3]), cvtpk(hi[0], hi[1]), cvtpk(hi[2], hi[3])}; } }
                __builtin_amdgcn_sched_barrier(0); }
    }
};
struct EpiSwiglu {
    bf16_t* act;
    __device__ __forceinline__ void operator()(const f32x4 (&acc)[2][2][4][2], const Unit& u, int wr, int wc, int fr, int fq) const {
        const int row0 = u.pm * BM + wr * 64 + fr, col0 = u.pn * HALF + wc * 32 + 8 * fq;
#pragma unroll
        for (int ai = 0; ai < 2; ++ai)
#pragma unroll
            for (int m = 0; m < 4; ++m) { const int row = opaque_i(row0 + ai * HALF + m * 16); float o[8];
#pragma unroll
                for (int n = 0; n < 2; ++n) { const f32x4 gt = acc[ai][0][m][n], up = acc[ai][1][m][n];
#pragma unroll
                    for (int j = 0; j < 4; ++j) o[4 * n + j] = gt[j] * sigmoidf_(gt[j]) * up[j]; }
                *(u32x4*)(act + (size_t)row * DFF + col0) = (u32x4){cvtpk(o[0], o[1]), cvtpk(o[2], o[3]), cvtpk(o[4], o[5]), cvtpk(o[6], o[7])};
                __builtin_amdgcn_sched_barrier(0); }
    }
};
}

struct EpiLora {
    float* dec; bf16_t* ab; bf16_t* gb; const float *w0_f, *w0_b, *a0_f, *a0_b;
    __device__ __forceinline__ void operator()(const f32x4 (&acc)[2][2][4][2], const pg8::Unit& u, int wr, int wc, int fr, int fq) const {
        const int kind = u.pn >> 2, row0 = u.pm * 256 + wr * 64 + fr, c0 = (u.pn & 3) * 256 + wc * 32 + 8 * fq;
        if (kind < 2) {
            const float* w0 = (kind ? w0_b : w0_f) + c0; float* d = dec + (size_t)kind * T * 1024 + c0;
            f32x4 w[2][2];
#pragma unroll
            for (int bj = 0; bj < 2; ++bj)
#pragma unroll
                for (int n = 0; n < 2; ++n) w[bj][n] = *(const f32x4*)(w0 + bj * 128 + n * 4);
#pragma unroll
            for (int ai = 0; ai < 2; ++ai)
#pragma unroll
                for (int m = 0; m < 4; ++m) { const int row = pg8::opaque_i(row0 + ai * 128 + m * 16);
#pragma unroll
                    for (int bj = 0; bj < 2; ++bj)
#pragma unroll
                        for (int n = 0; n < 2; ++n) { const f32x4 v = acc[ai][bj][m][n]; f32x4 o;
#pragma unroll
                            for (int j = 0; j < 4; ++j) o[j] = __expf(-0.6065306597126334f * sigmoidf_(w[bj][n][j] + v[j]));
                            *(f32x4*)(d + (size_t)row * 1024 + bj * 128 + n * 4) = o; }
                    __builtin_amdgcn_sched_barrier(0); }
        } else if (kind < 4) {
            const float* a0 = (kind == 3 ? a0_b : a0_f) + c0; bf16_t* d = ab + (size_t)(kind - 2) * ADS + c0;
            f32x4 w[2][2];
#pragma unroll
            for (int bj = 0; bj < 2; ++bj)
#pragma unroll
                for (int n = 0; n < 2; ++n) w[bj][n] = *(const f32x4*)(a0 + bj * 128 + n * 4);
#pragma unroll
            for (int ai = 0; ai < 2; ++ai)
#pragma unroll
                for (int m = 0; m < 4; ++m) { const int row = pg8::opaque_i(row0 + ai * 128 + m * 16);
#pragma unroll
                    for (int bj = 0; bj < 2; ++bj) { const f32x4 v0 = acc[ai][bj][m][0], v1 = acc[ai][bj][m][1], x0 = w[bj][0], x1 = w[bj][1];
                        *(u32x4*)(d + (size_t)row * 1024 + bj * 128) = (u32x4){cvtpk(sigmoidf_(x0[0] + v0[0]), sigmoidf_(x0[1] + v0[1])), cvtpk(sigmoidf_(x0[2] + v0[2]), sigmoidf_(x0[3] + v0[3])),
                                                                                cvtpk(sigmoidf_(x1[0] + v1[0]), sigmoidf_(x1[1] + v1[1])), cvtpk(sigmoidf_(x1[2] + v1[2]), sigmoidf_(x1[3] + v1[3]))}; }
                    __builtin_amdgcn_sched_barrier(0); }
        } else {
            bf16_t* d = gb + c0;
#pragma unroll
            for (int ai = 0; ai < 2; ++ai)
#pragma unroll
                for (int m = 0; m < 4; ++m) { const int row = pg8::opaque_i(row0 + ai * 128 + m * 16);
#pragma unroll
                    for (int bj = 0; bj < 2; ++bj) { const f32x4 v0 = acc[ai][bj][m][0], v1 = acc[ai][bj][m][1];
                        *(u32x4*)(d + (size_t)row * 1024 + bj * 128) = (u32x4){cvtpk(v0[0], v0[1]), cvtpk(v0[2], v0[3]), cvtpk(v1[0], v1[1]), cvtpk(v1[2], v1[3])}; }
                    __builtin_amdgcn_sched_barrier(0); }
        }
    }
};

__device__ __forceinline__ int down_unit_index(int pm, int pn) { const int wgid = (pm / pg8::WGM) * (pg8::WGM * 8) + pn * pg8::WGM + (pm % pg8::WGM); return (wgid % 80) * 8 + wgid / 80; }
struct EpiDown {
    const bf16_t* x1b; bf16_t* h2; bf16_t* part; const float* md; int split_from;
    __device__ __forceinline__ void operator()(const f32x4 (&acc)[2][2][4][2], const pg8::Unit& u, int wr, int wc, int fr, int fq) const {
        const int kh = u.pn >> 3, pn = u.pn & 7, row0 = u.pm * 256 + wr * 64 + fr, col0 = pn * 256 + wc * 32 + 8 * fq;
        bf16_t* pt = part + (size_t)(down_unit_index(u.pm, pn) - split_from) * 65536;
#pragma unroll
        for (int ai = 0; ai < 2; ++ai)
#pragma unroll
            for (int m = 0; m < 4; ++m) { const int row = pg8::opaque_i(row0 + ai * 128 + m * 16); const float* mg = md + cond_of(row) * 12288 + 5 * 2048;
#pragma unroll
                for (int bj = 0; bj < 2; ++bj) { const int col = col0 + bj * 128;
                    const f32x4 g0 = *(const f32x4*)(mg + col), g1 = *(const f32x4*)(mg + col + 4);
                    f32x4 o0 = g0 * acc[ai][bj][m][0], o1 = g1 * acc[ai][bj][m][1];
                    if (kh < 2) { float x[8]; unpack8(*(const u32x4*)(x1b + (size_t)row * 2048 + col), x);
                        o0 += ALPHA * (f32x4){x[0], x[1], x[2], x[3]}; o1 += ALPHA * (f32x4){x[4], x[5], x[6], x[7]};
                        *(u32x4*)(h2 + (size_t)row * 2048 + col) = (u32x4){cvtpk(o0[0], o0[1]), cvtpk(o0[2], o0[3]), cvtpk(o1[0], o1[1]), cvtpk(o1[2], o1[3])}; }
                    else *(u32x4*)(pt + (row & 255) * 256 + (col & 255)) = (u32x4){cvtpk(o0[0], o0[1]), cvtpk(o0[2], o0[3]), cvtpk(o1[0], o1[1]), cvtpk(o1[2], o1[3])}; }
                __builtin_amdgcn_sched_barrier(0); }
    }
};

template <class F> __device__ __forceinline__ void run_gemm(LAS unsigned char* lds, const bf16_t* A, const bf16_t* Bt, int M, int N, int K, int rot, bf16_t* out, int ld, int ncols, F f) {
    pg8::Gemm g{A, Bt, M, N, K}; pg8::StaticOrder S; int c_ = (int)blockIdx.x + rot; if (c_ >= (int)gridDim.x) c_ -= (int)gridDim.x; S.init(M, N, (int)gridDim.x, c_);
    pg8::EpiEach<F> E{f, out, ld, ncols};
    pg8::gemm_phase(lds, g, S, E);
}

namespace att {
constexpr int NW = 8, QBLK = 32, KVBLK = 64;
constexpr float SCALE = 0.07216878364870322f;
constexpr float THR = 8.f;
constexpr int LDQ = 1536, LDKV = 2048, LDKR = 64, LDO = 2048;
constexpr int SHM_V = KVBLK * 128 * 2, SHM_K = KVBLK * 192 * 2;
#define KSWZ(row, colB) ((row) * 384 + ((colB) ^ (((row) & 7) << 4)))
#define SBAR() __builtin_amdgcn_sched_barrier(0)
__device__ __forceinline__ int crow(int r, int hi) { return (r & 3) + 8 * (r >> 2) + 4 * hi; }
__device__ __forceinline__ void partialSM(f32x16& p0, f32x16& p1, float& m_reg, float& mn, float& alpha) {
    constexpr float C = SCALE * 1.4426950408889634f;
    float pmax = p0[0];
#pragma unroll
    for (int r = 1; r < 16; ++r) pmax = fmaxf(pmax, p0[r]);
#pragma unroll
    for (int r = 0; r < 16; ++r) pmax = fmaxf(pmax, p1[r]);
    { auto rr = __builtin_amdgcn_permlane32_swap(__float_as_uint(pmax), __float_as_uint(pmax), false, false);
      pmax = fmaxf(__uint_as_float(rr[0]), __uint_as_float(rr[1])); }
    if (__builtin_expect(__all(pmax - m_reg <= THR / SCALE), 1)) { mn = m_reg; alpha = 1.f; }
    else { mn = fmaxf(m_reg, pmax); alpha = __builtin_amdgcn_exp2f((m_reg - mn) * C); m_reg = mn; }
    float mnC = -mn * C;
#pragma unroll
    for (int r = 0; r < 16; ++r) p0[r] = fmaf(p0[r], C, mnC);
#pragma unroll
    for (int r = 0; r < 16; ++r) p1[r] = fmaf(p1[r], C, mnC);
#pragma unroll
    for (int r = 0; r < 16; ++r) p0[r] = __builtin_amdgcn_exp2f(p0[r]);
}
__device__ __forceinline__ void finishSM(f32x16& p0, f32x16& p1, float alpha, float& l_reg, bf16x8& pa0, bf16x8& pa1, bf16x8& pa2, bf16x8& pa3) {
#pragma unroll
    for (int r = 0; r < 16; ++r) p1[r] = __builtin_amdgcn_exp2f(p1[r]);
    float ps = 0;
#pragma unroll
    for (int r = 0; r < 16; ++r) ps += p0[r];
#pragma unroll
    for (int r = 0; r < 16; ++r) ps += p1[r];
    { auto rr = __builtin_amdgcn_permlane32_swap(__float_as_uint(ps), __float_as_uint(ps), false, false);
      ps = __uint_as_float(rr[0]) + __uint_as_float(rr[1]); }
    l_reg = l_reg * alpha + ps;
#define PK4(P, BASE, OUT) do { unsigned a0 = cvtpk(P[BASE + 0], P[BASE + 1]), a1 = cvtpk(P[BASE + 2], P[BASE + 3]);   \
    unsigned b0 = cvtpk(P[BASE + 4], P[BASE + 5]), b1 = cvtpk(P[BASE + 6], P[BASE + 7]);                              \
    auto r0 = __builtin_amdgcn_permlane32_swap(a0, b0, false, false); auto r1 = __builtin_amdgcn_permlane32_swap(a1, b1, false, false); \
    u32x4 w = {r0[0], r1[0], r0[1], r1[1]}; OUT = *reinterpret_cast<bf16x8*>(&w); } while (0)
    PK4(p0, 0, pa0); PK4(p0, 8, pa1); PK4(p1, 0, pa2); PK4(p1, 8, pa3);
#undef PK4
}
__device__ __forceinline__ void qkt(f32x16& p0, f32x16& p1, const char* Ks, const bf16x8* qr, int r32, int hi) {
    p0 = f32x16{}; p1 = f32x16{};
#pragma unroll
    for (int d0 = 0; d0 < 12; ++d0) { int cb = (d0 * 16 + hi * 8) * 2;
        bf16x8 b0 = *reinterpret_cast<const bf16x8*>(Ks + KSWZ(r32, cb));
        bf16x8 b1 = *reinterpret_cast<const bf16x8*>(Ks + KSWZ(32 + r32, cb));
        p0 = __builtin_amdgcn_mfma_f32_32x32x16_bf16(b0, qr[d0], p0, 0, 0, 0);
        p1 = __builtin_amdgcn_mfma_f32_32x32x16_bf16(b1, qr[d0], p1, 0, 0, 0); }
}
__device__ __forceinline__ int v_st(int k, int c) { const int kk = (k & ~0xC) | ((k & 4) << 1) | ((k & 8) >> 1); return ((kk >> 3) * 4 + (c >> 5)) * 512 + ((kk & 7) * 32 + (c & 31)) * 2; }
__device__ __forceinline__ int v_rd_base(int lane) { return ((lane & 3) << 3) | (((lane >> 2) & 3) << 6) | (((lane >> 4) & 1) << 5) | (((lane >> 5) & 1) << 8); }
constexpr int v_rd_off(int d0, int ks, int half) { return d0 * 512 + ks * 4096 + half * 2048; }
template <int OFF> __device__ __forceinline__ s16x4 tr_read(int vb) {
    s16x4 r; asm volatile("ds_read_b64_tr_b16 %0, %1 offset:%2" : "=&v"(r) : "v"(vb), "i"(OFF) : "memory"); return r;
}
template <int D0> __device__ __forceinline__ void pv_one(f32x16& od, int vb, bf16x8 pa0, bf16x8 pa1, bf16x8 pa2, bf16x8 pa3) {
    const s16x4 l0 = tr_read<v_rd_off(D0, 0, 0)>(vb), h0 = tr_read<v_rd_off(D0, 0, 1)>(vb), l1 = tr_read<v_rd_off(D0, 1, 0)>(vb), h1 = tr_read<v_rd_off(D0, 1, 1)>(vb);
    const s16x4 l2 = tr_read<v_rd_off(D0, 2, 0)>(vb), h2 = tr_read<v_rd_off(D0, 2, 1)>(vb), l3 = tr_read<v_rd_off(D0, 3, 0)>(vb), h3 = tr_read<v_rd_off(D0, 3, 1)>(vb);
    asm volatile("s_waitcnt lgkmcnt(0)" ::: "memory"); SBAR();
#define PK(L, H) (bf16x8){L[0], L[1], L[2], L[3], H[0], H[1], H[2], H[3]}
    od = __builtin_amdgcn_mfma_f32_32x32x16_bf16(pa0, PK(l0, h0), od, 0, 0, 0);
    od = __builtin_amdgcn_mfma_f32_32x32x16_bf16(pa1, PK(l1, h1), od, 0, 0, 0);
    od = __builtin_amdgcn_mfma_f32_32x32x16_bf16(pa2, PK(l2, h2), od, 0, 0, 0);
    od = __builtin_amdgcn_mfma_f32_32x32x16_bf16(pa3, PK(l3, h3), od, 0, 0, 0);
#undef PK
}
__device__ __forceinline__ void pv_d0(f32x16* o, int vb, bf16x8 pa0, bf16x8 pa1, bf16x8 pa2, bf16x8 pa3) {
    pv_one<0>(o[0], vb, pa0, pa1, pa2, pa3); pv_one<1>(o[1], vb, pa0, pa1, pa2, pa3); pv_one<2>(o[2], vb, pa0, pa1, pa2, pa3); pv_one<3>(o[3], vb, pa0, pa1, pa2, pa3);
}
__device__ __forceinline__ void attn_body(const bf16_t* __restrict__ Qb, const bf16_t* __restrict__ Kh, const bf16_t* __restrict__ Vh, const bf16_t* __restrict__ KRh,
                                          bf16_t* __restrict__ Ob, int seq, char* lds) {
    const int tid = threadIdx.x, wid = tid >> 6, lane = tid & 63, r32 = lane & 31, hi = lane >> 5;
    char* V_lds = lds; char* K_lds = lds + 2 * SHM_V;
    float* ws = (float*)(lds + 2 * SHM_V + 2 * SHM_K) + wid * 64; float* li_l = ws; float* al_l = ws + 32;
    float m_reg = -1e30f, l_reg = 0; f32x16 o[4] = {}; bf16x8 qr[12];
    const bf16_t* Qw = Qb + (long)(wid * QBLK + r32) * LDQ + hi * 8;
#pragma unroll
    for (int d0 = 0; d0 < 12; ++d0) qr[d0] = *reinterpret_cast<const bf16x8*>(Qw + d0 * 16);
    const int sr = tid >> 4, sc = (tid & 15) * 8, vst0 = v_st(sr, sc), vst1 = v_st(32 + sr, sc);
    const int rr = tid >> 3, rc = (tid & 7) * 8;
    const int vb0 = (int)(uintptr_t)V_lds + v_rd_base(lane);
    struct { bf16x8 vs0, vs1, ks0, ks1, kr0; } sr_[1];
#define SLOAD(i, k0) do { sr_[i].vs0 = *(const bf16x8*)(&Vh[(long)((k0) + sr) * LDKV + sc]); sr_[i].vs1 = *(const bf16x8*)(&Vh[(long)((k0) + 32 + sr) * LDKV + sc]); \
    sr_[i].ks0 = *(const bf16x8*)(&Kh[(long)((k0) + sr) * LDKV + sc]); sr_[i].ks1 = *(const bf16x8*)(&Kh[(long)((k0) + 32 + sr) * LDKV + sc]); \
    sr_[i].kr0 = *(const bf16x8*)(&KRh[(long)((k0) + rr) * LDKR + rc]); } while (0)
#define SWRITE(b, i) do { *(bf16x8*)(V_lds + (b) * SHM_V + vst0) = sr_[i].vs0;          \
    *(bf16x8*)(V_lds + (b) * SHM_V + vst1) = sr_[i].vs1; int kc = sc * 2;               \
    *(bf16x8*)(K_lds + (b) * SHM_K + KSWZ(sr, kc)) = sr_[i].ks0;                       \
    *(bf16x8*)(K_lds + (b) * SHM_K + KSWZ(32 + sr, kc)) = sr_[i].ks1;                  \
    *(bf16x8*)(K_lds + (b) * SHM_K + KSWZ(rr, 256 + rc * 2)) = sr_[i].kr0; } while (0)
#define SWAIT() asm volatile("s_waitcnt vmcnt(0)" ::: "memory")
#define RESC(a) do { if (__any((a) < 1.f)) { if (hi == 0) al_l[r32] = (a); asm volatile("s_waitcnt lgkmcnt(0)" ::: "memory"); \
    _Pragma("unroll") for (int d = 0; d < 4; ++d) _Pragma("unroll") for (int r = 0; r < 16; ++r) o[d][r] *= al_l[crow(r, hi)]; } } while (0)
    f32x16 p0, p1; float mn, al; bf16x8 pa0, pa1, pa2, pa3; const int NT = seq / KVBLK;
    SLOAD(0, 0); SWAIT(); SWRITE(0, 0); __syncthreads();
    for (int j = 0; j < NT; ++j) {
        const int bsel = j & 1; const bool more = j + 1 < NT;
        SBAR(); qkt(p0, p1, K_lds + bsel * SHM_K, qr, r32, hi);
        partialSM(p0, p1, m_reg, mn, al);
        RESC(al); SBAR();
        if (more) SLOAD(0, (j + 1) * KVBLK);
        SBAR();
        finishSM(p0, p1, al, l_reg, pa0, pa1, pa2, pa3); SBAR();
        pv_d0(o, vb0 + bsel * SHM_V, pa0, pa1, pa2, pa3);
        if (more) { SWAIT(); SWRITE(bsel ^ 1, 0); }
        __syncthreads();
    }
    if (hi == 0) li_l[r32] = l_reg; asm volatile("s_waitcnt lgkmcnt(0)" ::: "memory");
    float rli[16];
#pragma unroll
    for (int r = 0; r < 16; ++r) rli[r] = __builtin_amdgcn_rcpf(li_l[crow(r, hi)]);
    bf16_t* Ow = Ob + (long)(wid * QBLK) * LDO;
#pragma unroll
    for (int r = 0; r < 16; ++r) { int orow = crow(r, hi);
#pragma unroll
        for (int d0 = 0; d0 < 4; ++d0) Ow[(long)orow * LDO + d0 * 32 + r32] = f2bf(o[d0][r] * rli[r]); }
    __syncthreads();
#undef SLOAD
#undef SWRITE
#undef SWAIT
#undef RESC
}
}

template <class F> __device__ __forceinline__ void conv_weight(bf16_t* dst, int N, int K, F src, int b0 = 0, int nb = 0) {
    extern __shared__ __attribute__((aligned(16))) unsigned char cw_shm[];
    const int nkb = K / 64, items = (N / 64) * nkb;
    if (nb == 0) nb = gridDim.x;
    if ((int)blockIdx.x < b0) return;
    int tid_ = threadIdx.x; asm volatile("" : "+v"(tid_));
#pragma unroll 1
    for (int it = blockIdx.x - b0; it < items; it += nb) {
        const int tid = tid_, nl = tid & 63, kc = tid >> 6;
        const int n0 = (it / nkb) * 64, k0 = (it % nkb) * 64, n = n0 + nl;
        const int rho = n & 31, ns = (n & ~31) + 8 * ((rho & 15) >> 2) + 4 * (rho >> 4) + (rho & 3);
        u32x4 w;
        { float f[8];
#pragma unroll
          for (int i = 0; i < 8; ++i) f[i] = src(ns, k0 + kc * 8 + i);
          w = pack8(f); }
        __builtin_amdgcn_s_waitcnt(0xc07f); __builtin_amdgcn_s_barrier();
        *(u32x4*)(cw_shm + nl * 144 + kc * 16) = w;
        __builtin_amdgcn_s_waitcnt(0xc07f); __builtin_amdgcn_s_barrier();
        const int rr = tid >> 3, cc = tid & 7;
        *(u32x4*)(dst + (size_t)(n0 + rr) * K + k0 + cc * 8) = *(const u32x4*)(cw_shm + rr * 144 + cc * 16);
    }
    __syncthreads();
}

template <int I> __device__ __forceinline__ void fmac_bc(float& acc, float x, float y) {
    asm volatile("v_fmac_f32_dpp %0, %1, %2 row_newbcast:%3 row_mask:0xf bank_mask:0xf" : "+v"(acc) : "v"(x), "v"(y), "n"(I));
}
template <int I> __device__ __forceinline__ float mul_bc(float x, float y) {
    float r; asm volatile("v_mul_f32_dpp %0, %1, %2 row_newbcast:%3 row_mask:0xf bank_mask:0xf" : "=v"(r) : "v"(x), "v"(y), "n"(I)); return r;
}
__device__ __forceinline__ float red4rows(float x) {
    auto r = __builtin_amdgcn_permlane16_swap(__float_as_uint(x), __float_as_uint(x), false, false);
    float s = __uint_as_float(r[0]) + __uint_as_float(r[1]);
    auto q = __builtin_amdgcn_permlane32_swap(__float_as_uint(s), __float_as_uint(s), false, false);
    return __uint_as_float(q[0]) + __uint_as_float(q[1]);
}
template <int I> struct ScanStep {
    static __device__ __forceinline__ void sa(const float (&S)[16], float kk, float& a0, float& a1, float& a2, float& a3) {
        if ((I & 3) == 0) fmac_bc<I>(a0, kk, S[I]); else if ((I & 3) == 1) fmac_bc<I>(a1, kk, S[I]); else if ((I & 3) == 2) fmac_bc<I>(a2, kk, S[I]); else fmac_bc<I>(a3, kk, S[I]);
        ScanStep<I + 1>::sa(S, kk, a0, a1, a2, a3);
    }
    static __device__ __forceinline__ void p1(float (&t)[16], float kd, float vv) { t[I] = mul_bc<I>(kd, vv); ScanStep<I + 1>::p1(t, kd, vv); }
    static __device__ __forceinline__ void p2(float (&t)[16], float b, float sa) { fmac_bc<I>(t[I], b, sa); ScanStep<I + 1>::p2(t, b, sa); }
    static __device__ __forceinline__ void p3(float (&t)[16], float w, const float (&S)[16]) { fmac_bc<I>(t[I], w, S[I]); ScanStep<I + 1>::p3(t, w, S); }
    static __device__ __forceinline__ void p4(const float (&t)[16], float r, float& y0, float& y1, float& y2, float& y3) {
        if ((I & 3) == 0) fmac_bc<I>(y0, r, t[I]); else if ((I & 3) == 1) fmac_bc<I>(y1, r, t[I]); else if ((I & 3) == 2) fmac_bc<I>(y2, r, t[I]); else fmac_bc<I>(y3, r, t[I]);
        ScanStep<I + 1>::p4(t, r, y0, y1, y2, y3);
    }
};
template <> struct ScanStep<16> {
    static __device__ __forceinline__ void sa(const float (&)[16], float, float&, float&, float&, float&) {}
    static __device__ __forceinline__ void p1(float (&)[16], float, float) {}
    static __device__ __forceinline__ void p2(float (&)[16], float, float) {}
    static __device__ __forceinline__ void p3(float (&)[16], float, const float (&)[16]) {}
    static __device__ __forceinline__ void p4(const float (&)[16], float, float&, float&, float&, float&) {}
};
struct ScanRaw { bf16_t r, k, a, v; float w, rk; };
__device__ __forceinline__ void scan_one(const Params& p, int base, int N, int h, int dir, const float* s0, float* s_out, int wv, int lane) {
    const bf16_t* rb = (const bf16_t*)(p.ws + O_R); const bf16_t* kb = (const bf16_t*)(p.ws + O_K); const bf16_t* vb = (const bf16_t*)(p.ws + O_V);
    const bf16_t* ab = (const bf16_t*)(p.ws + O_A) + (size_t)dir * ADS; const float* wb = p.out + (size_t)dir * T * 1024; const float* rkb = (const float*)(p.ws + O_RK);
    bf16_t* yb = (bf16_t*)(p.ws + (dir ? O_YB : O_YF));
    const int kq = lane >> 4, vs = lane & 15, vrow = 16 * wv + vs, ch = h * 64 + lane;
    const float kkc = p.k_k[ch], kac = p.k_a[ch];
    float S[16];
#pragma unroll
    for (int i = 0; i < 16; ++i) S[i] = s0 ? s0[vrow * 64 + kq * 16 + i] : 0.f;
    const int step = dir ? -1 : 1; int row = base + (dir ? N - 1 : 0);
    constexpr int U = 8;
    ScanRaw cur[U], nxt[U];
#define SC_LOAD(dst, row0) do { _Pragma("unroll") for (int s = 0; s < U; ++s) { const size_t ro = (size_t)((row0) + s * step); \
        dst[s].r = rb[ro * 1024 + ch]; dst[s].k = kb[ro * 1024 + ch]; dst[s].a = ab[ro * 1024 + ch]; dst[s].v = vb[ro * 1024 + h * 64 + vrow]; \
        dst[s].w = wb[ro * 1024 + ch]; dst[s].rk = rkb[ro * 16 + h]; } } while (0)
    SC_LOAD(cur, row);
    __builtin_amdgcn_s_waitcnt(0x0F70);
    for (int blk = 0; blk < N / U; ++blk) {
        const bool more = (blk + 1 < N / U);
        if (more) SC_LOAD(nxt, row + U * step);
#pragma unroll
        for (int s = 0; s < U; ++s) {
            const float kf = bf2f(cur[s].k), af = bf2f(cur[s].a);
            float kk = kf * kkc * cur[s].rk, bb = kk * af, kd = kf * (1.f + (af - 1.f) * kac), rr = bf2f(cur[s].r), ww = cur[s].w;
            const float vv = bf2f(cur[s].v);
            asm volatile("s_nop 1" : "+v"(kk), "+v"(bb), "+v"(kd), "+v"(rr), "+v"(ww));
            float a0 = 0.f, a1 = 0.f, a2 = 0.f, a3 = 0.f;
            ScanStep<0>::sa(S, kk, a0, a1, a2, a3);
            const float sa = -red4rows((a0 + a1) + (a2 + a3));
            float y0 = 0.f, y1 = 0.f, y2 = 0.f, y3 = 0.f;
            float tt[16];
            ScanStep<0>::p1(tt, kd, vv); ScanStep<0>::p2(tt, bb, sa); ScanStep<0>::p3(tt, ww, S); ScanStep<0>::p4(tt, rr, y0, y1, y2, y3);
#pragma unroll
            for (int i = 0; i < 16; ++i) S[i] = tt[i];
            const float y = red4rows((y0 + y1) + (y2 + y3));
            if (kq == 0) yb[(size_t)(row + s * step) * 1024 + h * 64 + vrow] = f2bf(y);
        }
        row += U * step;
        if (more) {
#pragma unroll
            for (int s = 0; s < U; ++s) cur[s] = nxt[s];
        }
    }
#undef SC_LOAD
    if (s_out) {
#pragma unroll
        for (int i = 0; i < 16; ++i) s_out[vrow * 64 + kq * 16 + i] = S[i];
    }
}

template <int CTRL> __device__ __forceinline__ float dpp_mov(float x) { return __builtin_bit_cast(float, __builtin_amdgcn_update_dpp(0, __builtin_bit_cast(int, x), CTRL, 0xf, 0xf, true)); }
__device__ __forceinline__ float wave_sum_dpp(float x) {
    x += dpp_mov<0xB1>(x); x += dpp_mov<0x4E>(x); x += dpp_mov<0x141>(x); x += dpp_mov<0x140>(x);
    return red4rows(x);
}
namespace cs {
constexpr int TSB = 144, ARR = 16 * TSB;
constexpr int OFF_KK = 0, OFF_R = ARR, OFF_B = 2 * ARR, OFF_KD = 3 * ARR, OFF_BT = 4 * ARR, OFF_KDT = OFF_BT + 2048, OFF_G = OFF_KDT + 2048, WAVE_LDS = OFF_G + 256;
static_assert(8 * WAVE_LDS <= 131072, "scan LDS");
__device__ __forceinline__ bf16x8 mk8(u32x2 lo, u32x2 hi) { u32x4 w = {lo[0], lo[1], hi[0], hi[1]}; return __builtin_bit_cast(bf16x8, w); }
__device__ __forceinline__ bf16x8 mk8u(unsigned a, unsigned b, unsigned c, unsigned d) { u32x4 w = {a, b, c, d}; return __builtin_bit_cast(bf16x8, w); }
__device__ __forceinline__ bf16x8 frag_tm(const char* lds, int off, int s, int c16, int g) {
    const char* p = lds + off + c16 * TSB + s * 64 + g * 8; return mk8(*(const u32x2*)p, *(const u32x2*)(p + 32));
}
template <int TT> struct Solve {
    static __device__ __forceinline__ void run(float (&u)[4], const float (&abn)[4]) {
        constexpr int gt = TT >> 2, jt = TT & 3;
        const unsigned x = __float_as_uint(u[jt]);
        auto r16 = __builtin_amdgcn_permlane16_swap(x, x, false, false); const unsigned a = (gt & 1) ? r16[1] : r16[0];
        auto r32 = __builtin_amdgcn_permlane32_swap(a, a, false, false); const float ut = __uint_as_float((gt & 2) ? r32[1] : r32[0]);
        fmac_bc<TT>(u[0], abn[0], ut); fmac_bc<TT>(u[1], abn[1], ut); fmac_bc<TT>(u[2], abn[2], ut); fmac_bc<TT>(u[3], abn[3], ut);
        Solve<TT + 1>::run(u, abn);
    }
};
template <> struct Solve<15> { static __device__ __forceinline__ void run(float (&)[4], const float (&)[4]) {} };
template <int GB> struct BlockSolve {
    static __device__ __forceinline__ void run(float (&u)[4], const float (&abn)[4], unsigned pA0, unsigned pA1, int c16, int g) {
        float d1 = g == GB ? abn[1] : 0.f, d2 = g == GB ? abn[2] : 0.f, d3 = g == GB ? abn[3] : 0.f;
        asm volatile("s_nop 1" : "+v"(d1), "+v"(d2), "+v"(d3));
        fmac_bc<4 * GB + 0>(u[1], d1, u[0]);
        fmac_bc<4 * GB + 0>(u[2], d2, u[0]); fmac_bc<4 * GB + 1>(u[2], d2, u[1]);
        fmac_bc<4 * GB + 0>(u[3], d3, u[0]); fmac_bc<4 * GB + 1>(u[3], d3, u[1]); fmac_bc<4 * GB + 2>(u[3], d3, u[2]);
        if (GB < 3) {
            const bool on = (g == GB) && (c16 >= 4 * GB + 4);
            const bf16x8 A = mk8u(on ? pA0 : 0u, on ? pA1 : 0u, 0u, 0u), B = mk8u(cvtpk(u[0], u[1]), cvtpk(u[2], u[3]), 0u, 0u);
            f32x4 uu = {u[0], u[1], u[2], u[3]};
            uu = __builtin_amdgcn_mfma_f32_16x16x32_bf16(A, B, uu, 0, 0, 0);
            u[0] = uu[0]; u[1] = uu[1]; u[2] = uu[2]; u[3] = uu[3];
            BlockSolve<GB + 1>::run(u, abn, pA0, pA1, c16, g);
        }
    }
};
template <> struct BlockSolve<4> { static __device__ __forceinline__ void run(float (&)[4], const float (&)[4], unsigned, unsigned, int, int) {} };
struct Raw { bf16_t r[4], k[4], a[4]; float wo[4]; float w[16]; float rk; bf16_t v[4]; };
constexpr int GROUP_LDS = 2 * WAVE_LDS;
__device__ __forceinline__ void scan_chunked(const Params& p, char* glds, volatile LAS unsigned* cnt, unsigned& gc, int base, int N, int h, int dir, const float* s0, float* s_out, int wv, int lane) {
    const bf16_t* rb = (const bf16_t*)(p.ws + O_R) + h * 64; const bf16_t* kb = (const bf16_t*)(p.ws + O_K) + h * 64; const bf16_t* vb = (const bf16_t*)(p.ws + O_V) + h * 64;
    const bf16_t* ab = (const bf16_t*)(p.ws + O_A) + (size_t)dir * ADS + h * 64; const float* wb = p.out + (size_t)dir * T * 1024 + h * 64; const float* rkb = (const float*)(p.ws + O_RK) + h;
    bf16_t* yb = (bf16_t*)(p.ws + (dir ? O_YB : O_YF));
    const int c16 = lane & 15, g = lane >> 4, v0 = 16 * wv, ch = h * 64 + lane;
    const float kkc = p.k_k[ch], kac = p.k_a[ch], rkc = p.r_k[ch];
    float* bon = (float*)(p.ws + O_BON) + (size_t)dir * T * 16 + h;
    f32x4 ST[4];
#pragma unroll
    for (int tl = 0; tl < 4; ++tl) ST[tl] = s0 ? *(const f32x4*)(s0 + (v0 + c16) * 64 + 16 * tl + 4 * g) : (f32x4){0.f, 0.f, 0.f, 0.f};
    const int step = dir ? -1 : 1; int row = base + (dir ? N - 1 : 0);
    Raw raw; const unsigned lo2 = (unsigned)lane * 2u, lo4 = (unsigned)lane * 4u;
#define CS_LOAD(row0) do { _Pragma("unroll") for (int t = 0; t < 16; ++t) { const size_t ro = (size_t)__builtin_amdgcn_readfirstlane((row0) + t * step) * 1024; \
        raw.w[t] = *(const float*)((const char*)(wb + ro) + lo4); } \
        _Pragma("unroll") for (int tt = 0; tt < 4; ++tt) { const size_t ro = (size_t)__builtin_amdgcn_readfirstlane((row0) + (4 * wv + tt) * step) * 1024; \
        raw.r[tt] = *(const bf16_t*)((const char*)(rb + ro) + lo2); raw.k[tt] = *(const bf16_t*)((const char*)(kb + ro) + lo2); \
        raw.a[tt] = *(const bf16_t*)((const char*)(ab + ro) + lo2); raw.wo[tt] = *(const float*)((const char*)(wb + ro) + lo4); } \
        raw.rk = rkb[(size_t)((row0) + c16 * step) * 16]; \
        _Pragma("unroll") for (int jj = 0; jj < 4; ++jj) raw.v[jj] = vb[(size_t)((row0) + (4 * g + jj) * step) * 1024 + v0 + c16]; } while (0)
    CS_LOAD(row);
    const int nch = N >> 4;
    for (int c = 0; c < nch; ++c, ++gc) {
        char* lds = glds + (gc & 1u) * WAVE_LDS;
        const float q0 = (raw.w[0] * raw.w[1]) * (raw.w[2] * raw.w[3]), q1 = (raw.w[4] * raw.w[5]) * (raw.w[6] * raw.w[7]);
        const float q2 = (raw.w[8] * raw.w[9]) * (raw.w[10] * raw.w[11]), q3 = (raw.w[12] * raw.w[13]) * (raw.w[14] * raw.w[15]);
        const float q01 = q0 * q1, G15 = q01 * (q2 * q3);
        float G = wv == 0 ? 1.f : (wv == 1 ? q0 : (wv == 2 ? q01 : q01 * q2));
        float bh[4], kdh[4], bterm[4];
#pragma unroll
        for (int tt = 0; tt < 4; ++tt) {
            const float kf = bf2f(raw.k[tt]), af = bf2f(raw.a[tt]), rf = bf2f(raw.r[tt]);
            const float rkt = __builtin_bit_cast(float, __builtin_amdgcn_readlane(__builtin_bit_cast(int, raw.rk), 4 * wv + tt));
            const float kk = kf * kkc * rkt, bb = kk * af, kd = kf * (1.f + (af - 1.f) * kac);
            bterm[tt] = rf * kd * rkc;
            const float Gp = G; G *= raw.wo[tt]; const float iG = __builtin_amdgcn_rcpf(G);
            bh[tt] = bb * iG; kdh[tt] = kd * iG;
            const unsigned p1 = cvtpk(kk * Gp, rf * G), p2 = cvtpk(bh[tt], kdh[tt]);
            char* tp = lds + (4 * wv + tt) * TSB + lane * 2;
            *(bf16_t*)(tp + OFF_KK) = (bf16_t)p1; *(bf16_t*)(tp + OFF_R) = (bf16_t)(p1 >> 16);
            *(bf16_t*)(tp + OFF_B) = (bf16_t)p2; *(bf16_t*)(tp + OFF_KD) = (bf16_t)(p2 >> 16);
        }
        *(u32x2*)(lds + OFF_BT + lane * 32 + wv * 8) = (u32x2){cvtpk(bh[0] * G15, bh[1] * G15), cvtpk(bh[2] * G15, bh[3] * G15)};
        *(u32x2*)(lds + OFF_KDT + lane * 32 + wv * 8) = (u32x2){cvtpk(kdh[0] * G15, kdh[1] * G15), cvtpk(kdh[2] * G15, kdh[3] * G15)};
        if (wv == 0) *(float*)(lds + OFF_G + lane * 4) = G15;
        asm volatile("s_waitcnt lgkmcnt(0)" ::: "memory");
        if (lane == 0) __hip_atomic_fetch_add((LAS unsigned*)cnt, 1u, __ATOMIC_RELAXED, __HIP_MEMORY_SCOPE_WORKGROUP);
        { const unsigned target = 4u * (gc + 1u); unsigned sp = 0u;
          while (*cnt < target) { __builtin_amdgcn_s_sleep(1); if (++sp > (1u << 22)) break; } }
        asm volatile("" ::: "memory");
        const unsigned vlo = (unsigned)raw.v[0] | ((unsigned)raw.v[1] << 16), vhi = (unsigned)raw.v[2] | ((unsigned)raw.v[3] << 16);
        const int crow = row;
        row += 16 * step;
        if (c + 1 < nch) CS_LOAD(row);
        asm volatile("" ::: "memory");
        bf16x8 fKK[2], fR[2], fB[2], fKD[2], fS[2];
#pragma unroll
        for (int s = 0; s < 2; ++s) { fKK[s] = frag_tm(lds, OFF_KK, s, c16, g); fR[s] = frag_tm(lds, OFF_R, s, c16, g); fB[s] = frag_tm(lds, OFF_B, s, c16, g); fKD[s] = frag_tm(lds, OFF_KD, s, c16, g);
            fS[s] = mk8u(cvtpk(ST[2 * s][0], ST[2 * s][1]), cvtpk(ST[2 * s][2], ST[2 * s][3]), cvtpk(ST[2 * s + 1][0], ST[2 * s + 1][1]), cvtpk(ST[2 * s + 1][2], ST[2 * s + 1][3])); }
        const f32x4 z4 = {0.f, 0.f, 0.f, 0.f};
        f32x4 P = z4, Y = z4, Ab = z4, AbT = z4, AdT = z4, RbT = z4, RdT = z4;
#pragma unroll
        for (int s = 0; s < 2; ++s) {
            P = __builtin_amdgcn_mfma_f32_16x16x32_bf16(fKK[s], fS[s], P, 0, 0, 0);
            Y = __builtin_amdgcn_mfma_f32_16x16x32_bf16(fR[s], fS[s], Y, 0, 0, 0);
            Ab = __builtin_amdgcn_mfma_f32_16x16x32_bf16(fKK[s], fB[s], Ab, 0, 0, 0);
            AbT = __builtin_amdgcn_mfma_f32_16x16x32_bf16(fB[s], fKK[s], AbT, 0, 0, 0);
            AdT = __builtin_amdgcn_mfma_f32_16x16x32_bf16(fKD[s], fKK[s], AdT, 0, 0, 0);
            RbT = __builtin_amdgcn_mfma_f32_16x16x32_bf16(fB[s], fR[s], RbT, 0, 0, 0);
            RdT = __builtin_amdgcn_mfma_f32_16x16x32_bf16(fKD[s], fR[s], RdT, 0, 0, 0);
        }
        {
            float bx[4];
#pragma unroll
            for (int tt = 0; tt < 4; ++tt) { float x = bterm[tt]; x += dpp_mov<0xB1>(x); x += dpp_mov<0x4E>(x); x += dpp_mov<0x141>(x); x += dpp_mov<0x140>(x); bx[tt] = x; }
            const int l3 = lane & 3; float z = l3 == 0 ? bx[0] : (l3 == 1 ? bx[1] : (l3 == 2 ? bx[2] : bx[3]));
            z = red4rows(z);
            if (lane < 4) bon[(size_t)(crow + (4 * wv + lane) * step) * 16] = z;
        }
        float abn[4];
#pragma unroll
        for (int j = 0; j < 4; ++j) { const int m = 4 * g + j;
            abn[j] = c16 < m ? -Ab[j] : 0.f;
            AdT[j] = m < c16 ? AdT[j] : 0.f;
            AbT[j] = m < c16 ? -AbT[j] : 0.f;
            RbT[j] = m <= c16 ? RbT[j] : 0.f; RdT[j] = m <= c16 ? RdT[j] : 0.f; }
        const f32x4 acc = __builtin_amdgcn_mfma_f32_16x16x32_bf16(mk8u(cvtpk(AdT[0], AdT[1]), cvtpk(AdT[2], AdT[3]), 0u, 0u), mk8u(vlo, vhi, 0u, 0u), P, 0, 0, 0);
        float u[4] = {-acc[0], -acc[1], -acc[2], -acc[3]};
        {
            const unsigned pA0 = cvtpk(AbT[0], AbT[1]), pA1 = cvtpk(AbT[2], AbT[3]);
            BlockSolve<0>::run(u, abn, pA0, pA1, c16, g);
        }
        const bf16x8 UV = mk8u(cvtpk(u[0], u[1]), cvtpk(u[2], u[3]), vlo, vhi);
        Y = __builtin_amdgcn_mfma_f32_16x16x32_bf16(mk8u(cvtpk(RbT[0], RbT[1]), cvtpk(RbT[2], RbT[3]), cvtpk(RdT[0], RdT[1]), cvtpk(RdT[2], RdT[3])), UV, Y, 0, 0, 0);
#pragma unroll
        for (int tl = 0; tl < 4; ++tl) {
            const f32x4 gv = *(const f32x4*)(lds + OFF_G + (16 * tl + 4 * g) * 4);
            const int kr_ = 16 * tl + c16;
            const bf16x8 fa = mk8(*(const u32x2*)(lds + OFF_BT + kr_ * 32 + g * 8), *(const u32x2*)(lds + OFF_KDT + kr_ * 32 + g * 8));
            ST[tl] = __builtin_amdgcn_mfma_f32_16x16x32_bf16(fa, UV, ST[tl] * gv, 0, 0, 0);
        }
#pragma unroll
        for (int j = 0; j < 4; ++j) yb[(size_t)(crow + (4 * g + j) * step) * 1024 + h * 64 + v0 + c16] = f2bf(Y[j]);
        asm volatile("" ::: "memory");
    }
#undef CS_LOAD
    if (s_out) {
#pragma unroll
        for (int tl = 0; tl < 4; ++tl) *(f32x4*)(s_out + (v0 + c16) * 64 + 16 * tl + 4 * g) = ST[tl];
    }
}
}

#define XB_TMO      128
#define XB_XCNT(j)  (256  + 64 * (j))
#define XB_XSUB(j)  (1280 + 64 * (j))
#define XB_XGEN(j)  (2304 + 64 * (j))
#define XB_TOP      3328
#define XB_TOPGEN   3392
#define XCD_BAR_WORDS 3456
#define XB_SPIN_CAP (1u << 22)
__device__ __forceinline__ unsigned xb_ld(unsigned* p)              { return __hip_atomic_load(p, __ATOMIC_RELAXED, __HIP_MEMORY_SCOPE_AGENT); }
__device__ __forceinline__ unsigned xb_add(unsigned* p, unsigned v) { return __hip_atomic_fetch_add(p, v, __ATOMIC_RELAXED, __HIP_MEMORY_SCOPE_AGENT); }
__device__ __forceinline__ unsigned xb_xcc_id() { return (unsigned)__builtin_amdgcn_s_getreg((3 << 11) | 20) & 0xFu; }
#define XB_SPIN(cond, bar) do { unsigned _sp = 0; while (cond) { __builtin_amdgcn_s_sleep(1); \
    if ((++_sp & 255u) == 0u) { if (xb_ld(&(bar)[XB_TMO])) break; if (_sp > XB_SPIN_CAP) { atomicAdd(&(bar)[XB_TMO], 1u); break; } } } } while (0)
struct XcdBarrier { unsigned* bar; unsigned x; volatile LAS unsigned* st; };
__device__ __forceinline__ XcdBarrier xcd_barrier_post(unsigned* bar, volatile LAS unsigned* st) {
    XcdBarrier b; b.bar = bar; b.x = xb_xcc_id(); b.st = st;
    if (threadIdx.x == 0) (void)xb_add(&bar[XB_XCNT(b.x)], 1u);
    return b;
}
__device__ __forceinline__ void xcd_barrier_complete(unsigned* bar, unsigned x, unsigned& nloc, unsigned& nx) {
    const unsigned G = gridDim.x * gridDim.y * gridDim.z;
    unsigned sum, cnt, mine, sp = 0u;
    for (;;) {
        sum = 0u; cnt = 0u; mine = 0u;
#pragma unroll
        for (unsigned j = 0; j < 16; ++j) { const unsigned c = xb_ld(&bar[XB_XCNT(j)]); sum += c; cnt += (c > 0u) ? 1u : 0u; mine = (j == x) ? c : mine; }
        if (sum == G) break;
        __builtin_amdgcn_s_sleep(1);
        if ((++sp & 255u) == 0u) { if (xb_ld(&bar[XB_TMO])) break; if (sp > XB_SPIN_CAP) { atomicAdd(&bar[XB_TMO], 1u); break; } }
    }
    nloc = mine > 0u ? mine : 1u; nx = cnt > 0u ? cnt : 1u;
}
__device__ __forceinline__ void xcd_barrier(const XcdBarrier& b) {
    asm volatile("s_waitcnt vmcnt(0)" ::: "memory");
    __syncthreads();
    if (threadIdx.x == 0) {
        unsigned* bar = b.bar;
        __builtin_amdgcn_s_waitcnt(0);
        unsigned nloc = b.st[0], nx = b.st[1];
        if (nloc == 0u) { xcd_barrier_complete(bar, b.x, nloc, nx); b.st[0] = nloc; b.st[1] = nx; }
        const unsigned old = xb_add(&bar[XB_XSUB(b.x)], 1u);
        const unsigned gen = old / nloc;
        if (old + 1u == (gen + 1u) * nloc) {
            __builtin_amdgcn_fence(__ATOMIC_RELEASE, "agent");
            asm volatile("s_waitcnt vmcnt(0)" ::: "memory");
            const unsigned og = xb_add(&bar[XB_TOP], 1u);
            const unsigned tg = og / nx;
            if (og + 1u == (tg + 1u) * nx) xb_add(&bar[XB_TOPGEN], 1u);
            else XB_SPIN(xb_ld(&bar[XB_TOPGEN]) == tg, bar);
            __builtin_amdgcn_fence(__ATOMIC_ACQUIRE, "agent");
            xb_add(&bar[XB_XGEN(b.x)], 1u);
            asm volatile("s_waitcnt vmcnt(0)" ::: "memory");
        } else {
            XB_SPIN(xb_ld(&bar[XB_XGEN(b.x)]) == gen, bar);
            __builtin_amdgcn_fence(__ATOMIC_ACQUIRE, "agent");
            asm volatile("s_waitcnt vmcnt(0)" ::: "memory");
        }
    }
    __syncthreads();
}

__device__ __forceinline__ float wave_sum(float v) {
#pragma unroll
    for (int m = 32; m >= 1; m >>= 1) v += __shfl_xor(v, m);
    return v;
}

__global__ __launch_bounds__(512, 2) void mega(Params p) {
    extern __shared__ __attribute__((aligned(16))) unsigned char shm[];
    LAS unsigned char* lds = (LAS unsigned char*)shm;
    __shared__ uint4 xb_words;
    cg::grid_group grid = cg::this_grid();
    const int tid = threadIdx.x, wid = __builtin_amdgcn_readfirstlane(tid >> 6), lane = tid & 63, G = gridDim.x, bid = blockIdx.x;
    char* ws = p.ws;
    if (tid == 0) xb_words = make_uint4(0u, 0u, 0u, 0u);
    __syncthreads();
    const XcdBarrier xbar = xcd_barrier_post((unsigned*)(ws + O_BAR), (volatile LAS unsigned*)&xb_words);
    if (p.phase_lo < 0) grid.sync();
    float* mod = (float*)(ws + O_MOD);
#ifdef SYNCPROBE
    for (int i_ = 0; i_ < 16; ++i_) xcd_barrier(xbar);
#endif
        for (int rep_ = 0; rep_ < 1 + ((REPM >> 0) & 1); ++rep_) { if (rep_) xcd_barrier(xbar);
        if (((PHM >> 0) & 1) && p.phase_lo <= 0 && 0 < p.phase_hi) {
            float* sl = (float*)shm;
            for (int it = bid; it < 192; it += G) {
                const int kc = it / 6, cb = it % 6, k0 = kc * 64, col = cb * 2048 + tid * 4;
                __syncthreads();
                for (int i = tid; i < 576; i += 512) { const int c = i >> 6, kk = i & 63; const float x = c == 0 ? p.c_ctx[k0 + kk] : p.c[(c - 1) * DM + k0 + kk]; sl[i] = x * sigmoidf_(x); }
                __syncthreads();
                f32x4 acc[9];
#pragma unroll
                for (int c = 0; c < 9; ++c) acc[c] = (f32x4){0.f, 0.f, 0.f, 0.f};
                if (kc == 0) { const f32x4 b = *(const f32x4*)(p.b_mod + col);
#pragma unroll
                    for (int c = 0; c < 9; ++c) acc[c] = b; }
#pragma unroll 8
                for (int kk = 0; kk < 64; ++kk) {
                    const f32x4 w = *(const f32x4*)(p.w_mod + (size_t)(k0 + kk) * 12288 + col);
#pragma unroll
                    for (int c = 0; c < 9; ++c) { const float s = sl[c * 64 + kk]; acc[c] += w * s; }
                }
#pragma unroll
                for (int c = 0; c < 9; ++c)
#pragma unroll
                    for (int j = 0; j < 4; ++j) atomicAdd(mod + c * 12288 + col + j, acc[c][j]);
            }
            {
                float* ct = (float*)(ws + O_ROPE); float* st = ct + 2048 * 32;
                for (int i = bid * 512 + tid; i < 2048 * 32; i += G * 512) {
                    const int pos = i >> 5, f = i & 31; const int gr = pos >> 6, gc = pos & 63;
                    const float fr = powf(10000.f, -(float)(f & 15) / 16.f);
                    const float ang = (float)(f < 16 ? gr : gc) * fr;
                    ct[i] = (float)cos((double)ang); st[i] = (float)sin((double)ang);
                }
            }
            conv_weight((bf16_t*)(ws + O_WIN), INP, 2048, [&](int n, int k) -> float {
                if (n >= INC) return 0.f;
                int c = n; if (n >= 768 && n < 832) { const int q = n - 768; c = 768 + (q & 1) * 32 + (q >> 1); }
                return p.w_in[(size_t)k * INC + c]; });
            conv_weight((bf16_t*)(ws + O_WUQ), 1536, 512, [&](int n, int k) -> float {
                const int hh = n / 192, c = n % 192; int sc = c; if (c >= 128) { const int q = c - 128; sc = 128 + (q & 1) * 32 + (q >> 1); }
                return p.w_uq[(size_t)k * 1536 + hh * 192 + sc]; });
            conv_weight((bf16_t*)(ws + O_WKV), 2048, 256, [&](int n, int k) -> float { return n < 1024 ? p.w_uk[(size_t)k * 1024 + n] : p.w_uv[(size_t)k * 1024 + n - 1024]; });
            conv_weight((bf16_t*)(ws + O_WLO), 5120, 256, [&](int n, int k) -> float {
                const int kind = n >> 10, c = n & 1023;
                if (kind == 0) return k < 64 ? p.w_up_f[(size_t)k * 1024 + c] : 0.f;
                if (kind == 1) return k < 64 ? p.w_up_b[(size_t)k * 1024 + c] : 0.f;
                if (kind == 2) return (k >= 64 && k < 128) ? p.a_up_f[(size_t)(k - 64) * 1024 + c] : 0.f;
                if (kind == 3) return (k >= 64 && k < 128) ? p.a_up_b[(size_t)(k - 64) * 1024 + c] : 0.f;
                return k >= 128 ? p.g_up[(size_t)(k - 128) * 1024 + c] : 0.f; });
            conv_weight((bf16_t*)(ws + O_WOUT), 2048, 2048, [&](int n, int k) -> float { return p.w_out[(size_t)k * 2048 + n]; });
        }
        }
        if (p.phase_lo <= 0 && 0 + 1 < p.phase_hi) xcd_barrier(xbar);
        for (int rep_ = 0; rep_ < 1 + ((REPM >> 1) & 1); ++rep_) { if (rep_) xcd_barrier(xbar);
        if (((PHM >> 1) & 1) && p.phase_lo <= 1 && 1 < p.phase_hi) {
            bf16_t* xm = (bf16_t*)(ws + O_XM);
            const size_t NI = (size_t)T * 256, stride = (size_t)G * 512;
            for (size_t i = (size_t)bid * 512 + tid; i < NI; i += 4 * stride) {
                f32x4 xa[4][2];
#pragma unroll
                for (int u = 0; u < 4; ++u) { const size_t ii = i + u * stride; if (ii < NI) { const int row = (int)(ii >> 8), c0 = (int)(ii & 255) * 8; const float* xr = xrow(p, row) + c0;
                        xa[u][0] = ldntf(xr); xa[u][1] = ldntf(xr + 4); } }
#pragma unroll
                for (int u = 0; u < 4; ++u) { const size_t ii = i + u * stride; if (ii < NI) { const int row = (int)(ii >> 8), c0 = (int)(ii & 255) * 8; const float* m = mod + cond_of(row) * 12288;
                        const f32x4 sc0 = *(const f32x4*)(m + 2048 + c0), sc1 = *(const f32x4*)(m + 2048 + c0 + 4), sh0 = *(const f32x4*)(m + c0), sh1 = *(const f32x4*)(m + c0 + 4);
                        const f32x4 o0 = xa[u][0] * (1.f + sc0) + sh0, o1 = xa[u][1] * (1.f + sc1) + sh1;
                        *(u32x4*)(xm + (size_t)row * 2048 + c0) = (u32x4){cvtpk(o0[0], o0[1]), cvtpk(o0[2], o0[3]), cvtpk(o1[0], o1[1]), cvtpk(o1[2], o1[3])}; } }
            }
        }
        }
        if (p.phase_lo <= 1 && 1 + 1 < p.phase_hi) xcd_barrier(xbar);
        for (int rep_ = 0; rep_ < 1 + ((REPM >> 2) & 1); ++rep_) { if (rep_) xcd_barrier(xbar);
        if (((PHM >> 2) & 1) && p.phase_lo <= 2 && 2 < p.phase_hi) {
            bf16_t* proj = (bf16_t*)(ws + O_PROJ);
            run_gemm(lds, (const bf16_t*)(ws + O_XM), (const bf16_t*)(ws + O_WIN), T, INP, 2048, 0, proj, INC, INC, [=](int, int, f32x4 v) -> f32x4 { return v; });
            {
                const int nun = (T / 256) * (INP / 256), r = nun % G, b0 = r, nb = G - r;
                if (r > 0) conv_weight((bf16_t*)(ws + O_WGU), 11264, 2048, [&](int n, int k) -> float {
                    const int pt = n >> 8, j = n & 255; return j < 128 ? p.w_gate[(size_t)k * DFF + pt * 128 + j] : p.w_up[(size_t)k * DFF + pt * 128 + j - 128]; }, b0, nb);
                else conv_weight((bf16_t*)(ws + O_WGU), 11264, 2048, [&](int n, int k) -> float {
                    const int pt = n >> 8, j = n & 255; return j < 128 ? p.w_gate[(size_t)k * DFF + pt * 128 + j] : p.w_up[(size_t)k * DFF + pt * 128 + j - 128]; });
            }
        }
        }
        if (p.phase_lo <= 2 && 2 + 1 < p.phase_hi) xcd_barrier(xbar);
        for (int rep_ = 0; rep_ < 1 + ((REPM >> 3) & 1); ++rep_) { if (rep_) xcd_barrier(xbar);
        if (((PHM >> 3) & 1) && p.phase_lo <= 3 && 3 < p.phase_hi) {
            const bf16_t* proj = (const bf16_t*)(ws + O_PROJ);
            bf16_t* qn = (bf16_t*)(ws + O_QN); bf16_t* ckv = (bf16_t*)(ws + O_CKV); bf16_t* kr = (bf16_t*)(ws + O_KR); bf16_t* lin = (bf16_t*)(ws + O_LIN);
            bf16_t* rb = (bf16_t*)(ws + O_R); bf16_t* kb = (bf16_t*)(ws + O_K); bf16_t* vb = (bf16_t*)(ws + O_V); float* rkb = (float*)(ws + O_RK);
            const float* ct = (const float*)(ws + O_ROPE); const float* st = ct + 2048 * 32;
            {
                constexpr int R = 4;
                const bool shift = (wid >= 2) || (wid == 1 && lane >= 32);
                const int seg = (wid - 2) >> 1, gi = ((wid - 2) & 1) * 64 + lane;
                const int col = wid == 0 ? lane * 8 : (wid == 1 ? (lane < 32 ? 512 + lane * 8 : 3904 + (lane - 32) * 8) : 832 + seg * 1024 + gi * 8);
                float cw[8];
#pragma unroll
                for (int j = 0; j < 8; ++j) cw[j] = wid == 0 ? p.q_norm_g[col + j] : ((wid == 1 && lane < 32) ? p.kv_norm_g[col - 512 + j] : p.tok_mu[col - 832 + j]);
                float kkc[8];
#pragma unroll
                for (int j = 0; j < 8; ++j) kkc[j] = (wid == 4 || wid == 5) ? p.k_k[gi * 8 + j] : 0.f;
#define P3_LOAD(R0, CQ, PQ, NQ, KQ) do { _Pragma("unroll") for (int rr = 0; rr < R; ++rr) { \
                        const int row_ = (R0) + rr; const bf16_t* pr = proj + (size_t)row_ * INC; \
                        const bool ctx_ = row_ < TP; const int pos_ = ctx_ ? (row_ & 255) : ((row_ - TP) & 2047), len_ = ctx_ ? 256 : 2048; \
                        CQ[rr] = *(const u32x4*)(pr + col); \
                        if (rr == 0) PQ[0] = (shift && pos_ > 0) ? *(const u32x4*)(pr - INC + col) : (u32x4){0u, 0u, 0u, 0u};           \
                        if (rr == R - 1) NQ[0] = (shift && pos_ < len_ - 1) ? *(const u32x4*)(pr + INC + col) : (u32x4){0u, 0u, 0u, 0u}; \
                        KQ[rr] = (wid == 0 && lane < 8) ? *(const u32x4*)(pr + 768 + lane * 8) : (u32x4){0u, 0u, 0u, 0u}; } } while (0)
                u32x4 cq[R], pq[1], nq[1], kq4[R], cq2[R], pq2[1], nq2[1], kq42[R];
                P3_LOAD(bid * R, cq, pq, nq, kq4);
                for (int row0 = bid * R; row0 < T; row0 += G * R) {
                    if (row0 + G * R < T) P3_LOAD(row0 + G * R, cq2, pq2, nq2, kq42);
#pragma unroll
                    for (int rr = 0; rr < R; ++rr) {
                        const int row = row0 + rr;
                        const bool ctx = row < TP; const int pos = ctx ? (row & 255) : ((row - TP) & 2047); const int kvr = kvrow_of(row);
                        float x[8]; unpack8(cq[rr], x);
                        if (shift) { float p8[8], n8[8]; unpack8(rr == 0 ? pq[0] : cq[rr > 0 ? rr - 1 : 0], p8); unpack8(rr == R - 1 ? nq[0] : cq[rr < R - 1 ? rr + 1 : 0], n8);
#pragma unroll
                            for (int j = 0; j < 8; ++j) x[j] = x[j] + cw[j] * (0.5f * (p8[j] + n8[j]) - x[j]); }
                        if (wid == 0) {
                            float ss = 0.f;
#pragma unroll
                            for (int j = 0; j < 8; ++j) ss += x[j] * x[j];
                            ss = wave_sum(ss); const float rs = rsqrtf(ss * (1.f / 512.f) + RMS_EPS);
#pragma unroll
                            for (int j = 0; j < 8; ++j) x[j] = x[j] * rs * cw[j];
                            *(u32x4*)(qn + (size_t)row * 512 + lane * 8) = pack8(x);
                            if (lane < 8) {
                                float kx[8]; unpack8(kq4[rr], kx);
                                if (ctx) {
                                    float* o = p.out + OUT_KR + (size_t)row * 64;
#pragma unroll
                                    for (int j = 0; j < 4; ++j) { o[lane * 4 + j] = kx[2 * j]; o[32 + lane * 4 + j] = kx[2 * j + 1]; }
                                } else {
#pragma unroll
                                    for (int j = 0; j < 4; ++j) { const float cs = ct[pos * 32 + lane * 4 + j], sn = st[pos * 32 + lane * 4 + j]; const float x1 = kx[2 * j], x2 = kx[2 * j + 1];
                                        kx[2 * j] = x1 * cs - x2 * sn; kx[2 * j + 1] = x2 * cs + x1 * sn; }
                                }
                                *(u32x4*)(kr + (size_t)kvr * 64 + lane * 8) = pack8(kx);
                            }
                        } else if (wid == 1) {
                            float ss = 0.f;
#pragma unroll
                            for (int j = 0; j < 8; ++j) ss += x[j] * x[j];
#pragma unroll
                            for (int m = 16; m >= 1; m >>= 1) ss += __shfl_xor(ss, m);
                            if (lane < 32) {
                                const float rs = rsqrtf(ss * (1.f / 256.f) + RMS_EPS);
#pragma unroll
                                for (int j = 0; j < 8; ++j) x[j] = x[j] * rs * cw[j];
                                *(u32x4*)(ckv + (size_t)kvr * 256 + lane * 8) = pack8(x);
                                if (ctx) { float* o = p.out + OUT_CKV + (size_t)row * 256 + lane * 8; *(f32x4*)o = (f32x4){x[0], x[1], x[2], x[3]}; *(f32x4*)(o + 4) = (f32x4){x[4], x[5], x[6], x[7]}; }
                            } else {
                                const int l2 = lane - 32;
                                if (l2 < 8) {
#pragma unroll
                                    for (int j = 0; j < 8; ++j) x[j] = 1.f - 2.f * __builtin_amdgcn_rcpf(1.f + __expf(2.f * x[j]));
                                } else if (l2 >= 16) {
#pragma unroll
                                    for (int j = 0; j < 8; ++j) x[j] = sigmoidf_(x[j]);
                                }
                                *(u32x4*)(lin + (size_t)row * 256 + l2 * 8) = pack8(x);
                            }
                        } else {
                            const int c0 = gi * 8;
                            const u32x4 w = pack8(x);
                            bf16_t* dst = seg == 0 ? rb : (seg == 1 ? kb : vb);
                            *(u32x4*)(dst + (size_t)row * 1024 + c0) = w;
                            if (seg == 1) {
                                float kq[8]; unpack8(w, kq); float ss = 0.f;
#pragma unroll
                                for (int j = 0; j < 8; ++j) { const float t = kq[j] * kkc[j]; ss += t * t; }
                                ss += __shfl_xor(ss, 1); ss += __shfl_xor(ss, 2); ss += __shfl_xor(ss, 4);
                                if ((lane & 7) == 0) rkb[(size_t)row * 16 + (c0 >> 6)] = rsqrtf(fmaxf(ss, 1e-24f));
                            }
                        }
                    }
#pragma unroll
                    for (int rr = 0; rr < R; ++rr) { cq[rr] = cq2[rr]; kq4[rr] = kq42[rr]; }
                    pq[0] = pq2[0]; nq[0] = nq2[0];
                }
#undef P3_LOAD
            }
            for (int i = bid * 512 + tid; i < 2048 * 40; i += G * 512) {
                const int j = i / 40, gq = i % 40, b = j >> 8, ps = j & 255, kvr = TP + b * 2304 + 2048 + ps;
                if (gq < 32) {
                    const float* s = p.cache_ckv + (size_t)j * 256 + gq * 8; float f[8];
#pragma unroll
                    for (int e = 0; e < 8; ++e) f[e] = s[e];
                    *(u32x4*)(ckv + (size_t)kvr * 256 + gq * 8) = pack8(f);
                } else {
                    const int gg = gq - 32; const float* s = p.cache_krope + (size_t)j * 64; float f[8];
#pragma unroll
                    for (int e = 0; e < 4; ++e) { f[2 * e] = s[gg * 4 + e]; f[2 * e + 1] = s[32 + gg * 4 + e]; }
                    *(u32x4*)(kr + (size_t)kvr * 64 + gg * 8) = pack8(f);
                }
            }
        }
        }
        if (p.phase_lo <= 3 && 3 + 1 < p.phase_hi) xcd_barrier(xbar);
        for (int rep_ = 0; rep_ < 1 + ((REPM >> 4) & 1); ++rep_) { if (rep_) xcd_barrier(xbar);
        if (((PHM >> 4) & 1) && p.phase_lo <= 4 && 4 < p.phase_hi) {
            float* dec = p.out; bf16_t* ab = (bf16_t*)(ws + O_A); bf16_t* gb = (bf16_t*)(ws + O_G);
            pg8::Gemm g{(const bf16_t*)(ws + O_LIN), (const bf16_t*)(ws + O_WLO), T, 5120, 256}; pg8::StaticOrder S; S.init(T, 5120, G, bid);
            EpiLora E{dec, ab, gb, p.w0_f, p.w0_b, p.a0_f, p.a0_b};
            pg8::gemm_phase(lds, g, S, E);
        }
        }
        if (p.phase_lo <= 4 && 4 + 1 < p.phase_hi) xcd_barrier(xbar);
        for (int rep_ = 0; rep_ < 1 + ((REPM >> 5) & 1); ++rep_) { if (rep_) xcd_barrier(xbar);
        if (((PHM >> 5) & 1) && p.phase_lo <= 5 && 5 < p.phase_hi) {
            const int wv = wid & 3, grp = wid >> 2; char* gl = (char*)shm + grp * cs::GROUP_LDS;
            volatile LAS unsigned* cnt = (volatile LAS unsigned*)(lds + 2 * cs::GROUP_LDS + grp * 64);
            __syncthreads();
            if (tid == 0) { *(volatile LAS unsigned*)(lds + 2 * cs::GROUP_LDS) = 0u; *(volatile LAS unsigned*)(lds + 2 * cs::GROUP_LDS + 64) = 0u; }
            __syncthreads();
            unsigned gc = 0u;
            if (wid < 4) {
                for (int s = bid; s < 256; s += G) { const int b = s >> 5, h = (s >> 1) & 15, dir = s & 1;
                    cs::scan_chunked(p, gl, cnt, gc, TP + b * 2048, 2048, h, dir, (dir ? p.st_b : p.st_f) + (size_t)(b * 16 + h) * 4096, nullptr, wv, lane); }
            } else {
                for (int s = bid; s < 512; s += G) { const int b = s >> 5, h = (s >> 1) & 15, dir = s & 1;
                    cs::scan_chunked(p, gl, cnt, gc, b * 256, 256, h, dir, nullptr, p.out + (dir ? OUT_SB : OUT_SF) + (size_t)(b * 16 + h) * 4096, wv, lane); }
            }
        }
        }
        if (p.phase_lo <= 5 && 5 + 1 < p.phase_hi) xcd_barrier(xbar);
        for (int rep_ = 0; rep_ < 1 + ((REPM >> 6) & 1); ++rep_) { if (rep_) xcd_barrier(xbar);
        if (((PHM >> 6) & 1) && p.phase_lo <= 6 && 6 < p.phase_hi) {
            const bf16_t* yf = (const bf16_t*)(ws + O_YF); const bf16_t* yb = (const bf16_t*)(ws + O_YB);
            const bf16_t* vb = (const bf16_t*)(ws + O_V); const bf16_t* gb = (const bf16_t*)(ws + O_G);
            const float* bonf = (const float*)(ws + O_BON); const float* bonb = bonf + (size_t)T * 16;
            bf16_t* mix = (bf16_t*)p.out;
            const int c0 = (tid & 127) * 8, hd = c0 >> 6;
            float gg8[8], gb8[8];
#pragma unroll
            for (int j = 0; j < 8; ++j) { gg8[j] = p.gn_g[c0 + j]; gb8[j] = p.gn_b[c0 + j]; }
            const size_t NI = (size_t)T * 128, stride = (size_t)G * 512;
#define P6_LOAD(L_, B_, i_) do { _Pragma("unroll") for (int u = 0; u < 2; ++u) { const size_t ii = (i_) + u * stride; if (ii < NI) { const size_t rw_ = ii >> 7, o = rw_ * 1024 + c0; \
                        L_[u][0] = ldnt(yf + o); L_[u][1] = ldnt(yb + o); L_[u][2] = ldnt(vb + o); L_[u][3] = ldnt(gb + o); B_[u] = bonf[rw_ * 16 + hd] + bonb[rw_ * 16 + hd]; } } } while (0)
            u32x4 L[2][4], Ln[2][4]; float Bs[2], Bn[2];
            size_t i = (size_t)bid * 512 + tid;
            P6_LOAD(L, Bs, i);
            for (; i < NI; i += 2 * stride) {
                if (i + 2 * stride < NI) P6_LOAD(Ln, Bn, i + 2 * stride);
#pragma unroll
                for (int u = 0; u < 2; ++u) { const size_t ii = i + u * stride; if (ii < NI) { const size_t row = ii >> 7;
                    float y[8], t8[8], v8[8], g8[8];
                    unpack8(L[u][0], y); unpack8(L[u][1], t8); unpack8(L[u][2], v8); unpack8(L[u][3], g8);
                    const float sb = Bs[u]; float s1 = 0.f;
#pragma unroll
                    for (int j = 0; j < 8; ++j) { y[j] += t8[j]; s1 += y[j]; }
                    s1 += __shfl_xor(s1, 1); s1 += __shfl_xor(s1, 2); s1 += __shfl_xor(s1, 4);
                    const float mu = s1 * (1.f / 64.f); float s2 = 0.f;
#pragma unroll
                    for (int j = 0; j < 8; ++j) { y[j] -= mu; s2 += y[j] * y[j]; }
                    s2 += __shfl_xor(s2, 1); s2 += __shfl_xor(s2, 2); s2 += __shfl_xor(s2, 4);
                    const float rs = rsqrtf(s2 * (1.f / 64.f) + GN_EPS); float ov[8];
#pragma unroll
                    for (int j = 0; j < 8; ++j) ov[j] = (y[j] * rs * gg8[j] + gb8[j] + sb * v8[j]) * g8[j];
                    *(u32x4*)(mix + row * 2048 + 1024 + c0) = pack8(ov); } }
#pragma unroll
                for (int u = 0; u < 2; ++u) { Bs[u] = Bn[u];
#pragma unroll
                    for (int q = 0; q < 4; ++q) L[u][q] = Ln[u][q]; }
            }
#undef P6_LOAD
        }
        }
        if (p.phase_lo <= 6 && 6 + 1 < p.phase_hi) xcd_barrier(xbar);
        for (int rep_ = 0; rep_ < 1 + ((REPM >> 7) & 1); ++rep_) { if (rep_) xcd_barrier(xbar);
        if (((PHM >> 7) & 1) && p.phase_lo <= 7 && 7 < p.phase_hi) {
            bf16_t* q = (bf16_t*)(ws + O_Q); bf16_t* kvb = (bf16_t*)(ws + O_KVB);
            const float* ct = (const float*)(ws + O_ROPE); const float* st = ct + 2048 * 32;
            run_gemm(lds, (const bf16_t*)(ws + O_QN), (const bf16_t*)(ws + O_WUQ), T, 1536, 512, 0, q, 1536, 1536, [=](int row, int col, f32x4 v) -> f32x4 {
                const int c = col % 192;
                if (c >= 128 && row >= TP) { const int pos = (row - TP) & 2047, i = (c - 128) >> 1;
                    const float c0 = ct[pos * 32 + i], s0 = st[pos * 32 + i], c1 = ct[pos * 32 + i + 1], s1 = st[pos * 32 + i + 1];
                    const f32x4 t = v; v[0] = t[0] * c0 - t[1] * s0; v[1] = t[1] * c0 + t[0] * s0; v[2] = t[2] * c1 - t[3] * s1; v[3] = t[3] * c1 + t[2] * s1; }
                return v; });
            run_gemm(lds, (const bf16_t*)(ws + O_CKV), (const bf16_t*)(ws + O_WKV), KVROWS, 2048, 256, 224, kvb, 2048, 2048, [=](int, int, f32x4 v) -> f32x4 { return v; });
        }
        }
        if (p.phase_lo <= 7 && 7 + 1 < p.phase_hi) xcd_barrier(xbar);
        for (int rep_ = 0; rep_ < 1 + ((REPM >> 8) & 1); ++rep_) { if (rep_) xcd_barrier(xbar);
        if (((PHM >> 8) & 1) && p.phase_lo <= 8 && 8 < p.phase_hi) {
            const bf16_t* q = (const bf16_t*)(ws + O_Q); const bf16_t* kvb = (const bf16_t*)(ws + O_KVB); const bf16_t* kr = (const bf16_t*)(ws + O_KR);
            bf16_t* mix = (bf16_t*)p.out;
            const int xcd = bid & 7, slot = bid >> 3;
            for (int j = 0; ; ++j) {
                const int bh = j * (G >> 3) + xcd * (G >> 6) + (slot >> 3); if (bh >= 64 || (G >> 6) == 0) break;
                const int b = bh >> 3, h = bh & 7, qb = slot & 7; const size_t qrow = TP + (size_t)b * 2048 + qb * 256, kvr = TP + (size_t)b * 2304;
                att::attn_body(q + qrow * 1536 + h * 192, kvb + kvr * 2048 + h * 128, kvb + kvr * 2048 + 1024 + h * 128, kr + kvr * 64, mix + qrow * 2048 + h * 128, 2304, (char*)shm);
            }
            for (int it = bid; it < 128; it += G) {
                const int b = it >> 3, h = it & 7; const size_t qrow = (size_t)b * 256;
                att::attn_body(q + qrow * 1536 + h * 192, kvb + qrow * 2048 + h * 128, kvb + qrow * 2048 + 1024 + h * 128, kr + qrow * 64, mix + qrow * 2048 + h * 128, 256, (char*)shm);
            }
        }
        }
        if (p.phase_lo <= 8 && 8 + 1 < p.phase_hi) xcd_barrier(xbar);
        for (int rep_ = 0; rep_ < 1 + ((REPM >> 9) & 1); ++rep_) { if (rep_) xcd_barrier(xbar);
        if (((PHM >> 9) & 1) && p.phase_lo <= 9 && 9 < p.phase_hi) {
            bf16_t* h1 = (bf16_t*)(ws + O_H1); const Params* pp = &p; const float* md = mod;
            run_gemm(lds, (const bf16_t*)p.out, (const bf16_t*)(ws + O_WOUT), T, 2048, 2048, 0, h1, 2048, 2048, [=](int row, int col, f32x4 v) -> f32x4 {
                const f32x4 x = *(const f32x4*)(xrow(*pp, row) + col); const f32x4 g1 = *(const f32x4*)(md + cond_of(row) * 12288 + 4096 + col);
                return ALPHA * x + g1 * v; });
            {
                const int b0 = (640 - 2 * G > 0 && 640 - 2 * G < G) ? 640 - 2 * G : 0, nb = G - b0;
                conv_weight((bf16_t*)(ws + O_WDN), 2048, DFF, [&](int n, int k) -> float { return p.w_down[(size_t)k * 2048 + n]; }, b0, nb);
            }
        }
        }
        if (p.phase_lo <= 9 && 9 + 1 < p.phase_hi) xcd_barrier(xbar);
        for (int rep_ = 0; rep_ < 1 + ((REPM >> 10) & 1); ++rep_) { if (rep_) xcd_barrier(xbar);
        if (((PHM >> 10) & 1) && p.phase_lo <= 10 && 10 < p.phase_hi) {
            const bf16_t* h1 = (const bf16_t*)(ws + O_H1); bf16_t* hm = (bf16_t*)(ws + O_XM); bf16_t* x1b = (bf16_t*)p.out;
#define LNC(j) (((j) >> 1) * 512 + lane * 8 + ((j) & 1) * 4)
#define LDBF8(dst, q, ptr) do { const u32x4 w_ = __builtin_nontemporal_load((const u32x4*)(ptr)); \
                dst[2 * (q)] = (f32x4){__uint_as_float(w_[0] << 16), __uint_as_float(w_[0] & 0xffff0000u), __uint_as_float(w_[1] << 16), __uint_as_float(w_[1] & 0xffff0000u)}; \
                dst[2 * (q) + 1] = (f32x4){__uint_as_float(w_[2] << 16), __uint_as_float(w_[2] & 0xffff0000u), __uint_as_float(w_[3] << 16), __uint_as_float(w_[3] & 0xffff0000u)}; } while (0)
            f32x4 lg[8], lb[8];
#pragma unroll
            for (int j = 0; j < 8; ++j) { lg[j] = *(const f32x4*)(p.ln1_g + LNC(j)); lb[j] = *(const f32x4*)(p.ln1_b + LNC(j)); }
            int row = bid * 8 + wid; f32x4 x[8], xn[8];
#pragma unroll
            for (int q = 0; q < 4; ++q) LDBF8(x, q, h1 + (size_t)row * 2048 + q * 512 + lane * 8);
            for (; row < T; row += G * 8) {
                const int nrow = row + G * 8;
                if (nrow < T) {
#pragma unroll
                    for (int q = 0; q < 4; ++q) LDBF8(xn, q, h1 + (size_t)nrow * 2048 + q * 512 + lane * 8); }
                float s = 0.f;
#pragma unroll
                for (int j = 0; j < 8; ++j) s += (x[j][0] + x[j][1]) + (x[j][2] + x[j][3]);
                const float mu = wave_sum(s) * (1.f / 2048.f); float s2 = 0.f;
#pragma unroll
                for (int j = 0; j < 8; ++j) { x[j] -= mu; s2 += (x[j][0] * x[j][0] + x[j][1] * x[j][1]) + (x[j][2] * x[j][2] + x[j][3] * x[j][3]); }
                const float rs = rsqrtf(wave_sum(s2) * (1.f / 2048.f) + LN_EPS); const float* m = mod + cond_of(row) * 12288;
#pragma unroll
                for (int q = 0; q < 4; ++q) { const int c = q * 512 + lane * 8;
                    const f32x4 y0 = x[2 * q] * rs * lg[2 * q] + lb[2 * q], y1 = x[2 * q + 1] * rs * lg[2 * q + 1] + lb[2 * q + 1];
                    *(u32x4*)(x1b + (size_t)row * 2048 + c) = (u32x4){cvtpk(y0[0], y0[1]), cvtpk(y0[2], y0[3]), cvtpk(y1[0], y1[1]), cvtpk(y1[2], y1[3])};
                    const f32x4 z0 = y0 * (1.f + *(const f32x4*)(m + 4 * 2048 + c)) + *(const f32x4*)(m + 3 * 2048 + c);
                    const f32x4 z1 = y1 * (1.f + *(const f32x4*)(m + 4 * 2048 + c + 4)) + *(const f32x4*)(m + 3 * 2048 + c + 4);
                    *(u32x4*)(hm + (size_t)row * 2048 + c) = (u32x4){cvtpk(z0[0], z0[1]), cvtpk(z0[2], z0[3]), cvtpk(z1[0], z1[1]), cvtpk(z1[2], z1[3])}; }
#pragma unroll
                for (int j = 0; j < 8; ++j) x[j] = xn[j];
            }
        }
        }
        if (p.phase_lo <= 10 && 10 + 1 < p.phase_hi) xcd_barrier(xbar);
        for (int rep_ = 0; rep_ < 1 + ((REPM >> 11) & 1); ++rep_) { if (rep_) xcd_barrier(xbar);
        if (((PHM >> 11) & 1) && p.phase_lo <= 11 && 11 < p.phase_hi) {
            pg8::Gemm g{(const bf16_t*)(ws + O_XM), (const bf16_t*)(ws + O_WGU), T, 11264, 2048}; pg8::StaticOrder S; S.init(T, 11264, G, bid);
            pg8::EpiSwiglu E{(bf16_t*)(ws + O_ACT)};
            pg8::gemm_phase(lds, g, S, E);
        }
        }
        if (p.phase_lo <= 11 && 11 + 1 < p.phase_hi) xcd_barrier(xbar);
        for (int rep_ = 0; rep_ < 1 + ((REPM >> 12) & 1); ++rep_) { if (rep_) xcd_barrier(xbar);
        if (((PHM >> 12) & 1) && p.phase_lo <= 12 && 12 < p.phase_hi) {
            pg8::Gemm g{(const bf16_t*)(ws + O_ACT), (const bf16_t*)(ws + O_WDN), T, 2048, DFF, 8}; pg8::StaticOrder S; S.init(T, 2048, G, bid);
            { const int r = S.nwg % G; if (r > 0 && 2 * r <= G) S.split_from = S.nwg - r; }
            EpiDown E{(const bf16_t*)p.out, (bf16_t*)(ws + O_XM), (bf16_t*)(ws + O_PART), mod, S.split_from < S.nwg ? S.split_from : S.nwg};
            pg8::gemm_phase(lds, g, S, E);
        }
        }
        if (p.phase_lo <= 12 && 12 + 1 < p.phase_hi) xcd_barrier(xbar);
        for (int rep_ = 0; rep_ < 1 + ((REPM >> 13) & 1); ++rep_) { if (rep_) xcd_barrier(xbar);
        if (((PHM >> 13) & 1) && p.phase_lo <= 13 && 13 < p.phase_hi) {
            f32x4 lg[8], lb[8];
#pragma unroll
            for (int j = 0; j < 8; ++j) { lg[j] = *(const f32x4*)(p.ln2_g + LNC(j)); lb[j] = *(const f32x4*)(p.ln2_b + LNC(j)); }
            int row = bid * 8 + wid; f32x4 x[8], xn[8]; const bf16_t* h2 = (const bf16_t*)(ws + O_XM);
            const bf16_t* part = (const bf16_t*)(ws + O_PART); const int sfrom = (640 % G > 0 && 2 * (640 % G) <= G) ? 640 - 640 % G : 640;
#define P13_LD(dst, r_) do { _Pragma("unroll") for (int q = 0; q < 4; ++q) { const int col_ = q * 512 + lane * 8; LDBF8(dst, q, h2 + (size_t)(r_) * 2048 + col_); \
                const int ui_ = down_unit_index((r_) >> 8, col_ >> 8); \
                if (ui_ >= sfrom) { float pf[8]; unpack8(*(const u32x4*)(part + (size_t)(ui_ - sfrom) * 65536 + ((r_) & 255) * 256 + (col_ & 255)), pf); \
                    dst[2 * q] += (f32x4){pf[0], pf[1], pf[2], pf[3]}; dst[2 * q + 1] += (f32x4){pf[4], pf[5], pf[6], pf[7]}; } } } while (0)
            P13_LD(x, row);
            for (; row < T; row += G * 8) {
                const int nrow = row + G * 8;
                if (nrow < T) P13_LD(xn, nrow);
                float* hr = p.out + (size_t)row * 2048; float s = 0.f;
#pragma unroll
                for (int j = 0; j < 8; ++j) s += (x[j][0] + x[j][1]) + (x[j][2] + x[j][3]);
                const float mu = wave_sum(s) * (1.f / 2048.f); float s2 = 0.f;
#pragma unroll
                for (int j = 0; j < 8; ++j) { x[j] -= mu; s2 += (x[j][0] * x[j][0] + x[j][1] * x[j][1]) + (x[j][2] * x[j][2] + x[j][3] * x[j][3]); }
                const float rs = rsqrtf(wave_sum(s2) * (1.f / 2048.f) + LN_EPS);
#pragma unroll
                for (int j = 0; j < 8; ++j) stntf(hr + LNC(j), x[j] * rs * lg[j] + lb[j]);
#pragma unroll
                for (int j = 0; j < 8; ++j) x[j] = xn[j];
            }
        }
        }
        if (p.phase_lo <= 13 && 13 + 1 < p.phase_hi) xcd_barrier(xbar);
}

extern "C" void kernel_launch(void* const* d_in, const int* in_sizes, int n_in, void* d_out, int out_size, void* d_ws, size_t ws_size, hipStream_t stream) {
    constexpr size_t kDynLds = 131072;
    static int grid_blocks = 0;
    if (!grid_blocks) {
        if (ws_size < WS_END) { fprintf(stderr, "kernel_launch: workspace too small: %zu < %zu\n", ws_size, (size_t)WS_END); return; }
        if (hipFuncSetAttribute((const void*)mega, hipFuncAttributeMaxDynamicSharedMemorySize, (int)kDynLds) != hipSuccess) { fprintf(stderr, "kernel_launch: LDS attribute failed\n"); return; }
        int dev = 0, cus = 0, per_cu = 0;
        hipGetDevice(&dev);
        hipDeviceGetAttribute(&cus, hipDeviceAttributeMultiprocessorCount, dev);
        hipOccupancyMaxActiveBlocksPerMultiprocessor(&per_cu, mega, 512, kDynLds);
        if (per_cu < 1) { fprintf(stderr, "kernel_launch: occupancy 0\n"); return; }
        grid_blocks = cus;
    }
    Params p{};
    const float* const* in = (const float* const*)d_in;
    p.x_prompt = in[0]; p.x_sample = in[1]; p.cache_ckv = in[2]; p.cache_krope = in[3]; p.st_f = in[4]; p.st_b = in[5]; p.c = in[6]; p.c_ctx = in[7];
    p.w_mod = in[8]; p.b_mod = in[9]; p.w_in = in[10]; p.q_norm_g = in[11]; p.kv_norm_g = in[12]; p.w_uq = in[13]; p.w_uk = in[14]; p.w_uv = in[15];
    p.tok_mu = in[16]; p.w0_f = in[17]; p.w_up_f = in[18]; p.a0_f = in[19]; p.a_up_f = in[20]; p.w0_b = in[21]; p.w_up_b = in[22]; p.a0_b = in[23]; p.a_up_b = in[24];
    p.g_up = in[25]; p.k_k = in[26]; p.k_a = in[27]; p.r_k = in[28]; p.gn_g = in[29]; p.gn_b = in[30]; p.w_out = in[31]; p.ln1_g = in[32]; p.ln1_b = in[33];
    p.w_gate = in[34]; p.w_up = in[35]; p.w_down = in[36]; p.ln2_g = in[37]; p.ln2_b = in[38];
    p.out = (float*)d_out; p.ws = (char*)d_ws; p.phase_lo = 0; p.phase_hi = 14;
    hipMemsetAsync((char*)d_ws + O_MOD, 0, (size_t)(O_RK - O_MOD), stream);
    void* args[] = {&p};
    hipError_t e = hipLaunchCooperativeKernel((void*)mega, dim3(grid_blocks), dim3(512), args, kDynLds, stream);
    if (e != hipSuccess) fprintf(stderr, "cooperative launch failed: %s (grid %d)\n", hipGetErrorString(e), grid_blocks);
}
```

```cpp
#include <hip/hip_runtime.h>
#include <hip/hip_cooperative_groups.h>
#include <cstdio>
#include <cstdint>
namespace cg = cooperative_groups;
#ifndef PHM
#define PHM 0x3fff
#endif
#ifndef REPM
#define REPM 0
#endif

#define LAS __attribute__((address_space(3)))
typedef unsigned short bf16_t;
typedef short bf16x8 __attribute__((ext_vector_type(8)));
typedef short s16x4 __attribute__((ext_vector_type(4)));
typedef float f32x4 __attribute__((ext_vector_type(4)));
typedef float f32x2 __attribute__((ext_vector_type(2)));
typedef float f32x16 __attribute__((ext_vector_type(16)));
typedef unsigned u32x4 __attribute__((ext_vector_type(4)));
typedef unsigned u32x2 __attribute__((ext_vector_type(2)));

constexpr int DM = 2048, TP = 4096, TS = 16384, T = TP + TS;
constexpr int KVROWS = TP + 8 * 2304;
constexpr int INC = 4160, INP = 4352;
constexpr int DFF = 5632;
constexpr float ALPHA = 1.189207115002721f;
constexpr float LN_EPS = 1e-5f, RMS_EPS = 1e-6f, GN_EPS = 64e-5f;

constexpr size_t al256(size_t x) { return (x + 255) / 256 * 256; }
constexpr size_t PADU = 256 * 37;
constexpr int XCD_BAR_WORDS_C = 3456;
constexpr size_t O_WIN = 0;
constexpr size_t O_WUQ = O_WIN + al256((size_t)INP * 2048 * 2);
constexpr size_t O_WKV = O_WUQ + al256((size_t)1536 * 512 * 2);
constexpr size_t O_WLO = O_WKV + al256((size_t)2048 * 256 * 2);
constexpr size_t O_WOUT = O_WLO + al256((size_t)5120 * 256 * 2);
constexpr size_t O_MOD = O_WOUT + al256((size_t)2048 * 2048 * 2);
constexpr size_t O_BAR = O_MOD + al256((size_t)9 * 12288 * 4);
constexpr size_t O_RK = O_BAR + al256((size_t)XCD_BAR_WORDS_C * 4);
constexpr size_t O_ROPE = O_RK + al256((size_t)T * 16 * 4);
constexpr size_t O_RF = O_ROPE + al256((size_t)2 * 2048 * 32 * 4);
constexpr size_t O_WGU = O_RF;
constexpr size_t O_WDN = O_WGU + al256((size_t)11264 * 2048 * 2);
constexpr size_t O_R1 = O_WDN + al256((size_t)2048 * 5632 * 2);
constexpr size_t O_XM = O_R1;
constexpr size_t O_QN = O_R1;
constexpr size_t O_CKV = O_QN + al256((size_t)T * 512 * 2);
constexpr size_t O_KR = O_CKV + al256((size_t)KVROWS * 256 * 2);
constexpr size_t O_LIN = O_KR + al256((size_t)KVROWS * 64 * 2);
constexpr size_t O_R2 = O_R1 + al256((size_t)T * 2048 * 2);
constexpr size_t O_PROJ = O_R2;
constexpr size_t O_A = O_R2;
constexpr size_t ADS = (size_t)T * 1024 + PADU / 2;
constexpr size_t O_G = O_A + 2 * ADS * 2 + 3 * PADU;
constexpr size_t O_YB = O_G + (size_t)T * 1024 * 2 + 5 * PADU;
constexpr size_t O_KVB = O_R2;
constexpr size_t O_Q = O_KVB + al256((size_t)KVROWS * 2048 * 2);
constexpr size_t O_H1 = O_R2;
constexpr size_t O_ACT = O_R2;
constexpr size_t O_R3 = O_R2 + al256((size_t)T * INC * 2);
constexpr size_t O_PART = O_ACT + al256((size_t)T * DFF * 2);
constexpr size_t O_R = O_R3;
constexpr size_t O_K = O_R + (size_t)T * 1024 * 2 + 7 * PADU;
constexpr size_t O_V = O_K + (size_t)T * 1024 * 2 + 11 * PADU;
constexpr size_t O_YF = O_R3 + al256((size_t)3 * T * 1024 * 2 + 32 * PADU) + 13 * PADU;
constexpr size_t O_BON = O_YF + al256((size_t)T * 1024 * 2) + PADU;
constexpr size_t WS_END = O_BON + al256((size_t)2 * T * 16 * 4);
static_assert(O_YB + (size_t)T * 1024 * 2 <= O_R3, "R2 overflow (a,g,yb)");
static_assert(O_Q + (size_t)T * 1536 * 2 <= O_R3, "R2 overflow (kv,q)");
static_assert(O_ACT + (size_t)T * DFF * 2 <= WS_END, "act overflow");
static_assert(O_LIN + (size_t)T * 256 * 2 <= O_R2, "R1 overflow");
constexpr size_t OUT_CKV = (size_t)T * 2048, OUT_KR = OUT_CKV + 16 * 256 * 256, OUT_SF = OUT_KR + 16 * 256 * 64, OUT_SB = OUT_SF + 16 * 16 * 4096;

struct Params {
    const float *x_prompt, *x_sample, *cache_ckv, *cache_krope, *st_f, *st_b, *c, *c_ctx, *w_mod, *b_mod, *w_in, *q_norm_g, *kv_norm_g, *w_uq, *w_uk, *w_uv,
        *tok_mu, *w0_f, *w_up_f, *a0_f, *a_up_f, *w0_b, *w_up_b, *a0_b, *a_up_b, *g_up, *k_k, *k_a, *r_k, *gn_g, *gn_b, *w_out, *ln1_g, *ln1_b, *w_gate, *w_up,
        *w_down, *ln2_g, *ln2_b;
    float* out; char* ws;
    int phase_lo, phase_hi;
};

__device__ __forceinline__ float bf2f(bf16_t v) { return __uint_as_float(((unsigned)v) << 16); }
__device__ __forceinline__ bf16_t f2bf(float f) { unsigned u = __float_as_uint(f); u += 0x7FFFu + ((u >> 16) & 1u); return (bf16_t)(u >> 16); }
__device__ __forceinline__ unsigned cvtpk(float lo, float hi) { unsigned r; asm volatile("v_cvt_pk_bf16_f32 %0, %1, %2" : "=v"(r) : "v"(lo), "v"(hi)); return r; }
__device__ __forceinline__ void unpack8(u32x4 w, float (&f)[8]) {
#pragma unroll
    for (int i = 0; i < 4; ++i) { f[2 * i] = __uint_as_float(w[i] << 16); f[2 * i + 1] = __uint_as_float(w[i] & 0xffff0000u); }
}
__device__ __forceinline__ u32x4 pack8(const float (&f)[8]) { u32x4 w = {cvtpk(f[0], f[1]), cvtpk(f[2], f[3]), cvtpk(f[4], f[5]), cvtpk(f[6], f[7])}; return w; }
__device__ __forceinline__ u32x4 ldnt(const void* p) { return *(const u32x4*)p; }
__device__ __forceinline__ f32x4 ldntf(const float* p) { return *(const f32x4*)p; }
__device__ __forceinline__ void stntf(float* p, f32x4 v) { __builtin_nontemporal_store(v, (f32x4*)p); }
__device__ __forceinline__ float sigmoidf_(float x) { float r = __builtin_amdgcn_rcpf(1.f + __expf(-x)); asm volatile("s_nop 1" : "+v"(r)); return r; }
__device__ __forceinline__ const float* xrow(const Params& p, int row) { return row < TP ? p.x_prompt + (size_t)row * DM : p.x_sample + (size_t)(row - TP) * DM; }
__device__ __forceinline__ int cond_of(int row) { return row < TP ? 0 : 1 + ((row - TP) >> 11); }
__device__ __forceinline__ int kvrow_of(int row) { return row < TP ? row : TP + ((row - TP) >> 11) * 2304 + ((row - TP) & 2047); }

namespace pg8 {
constexpr int BM = 256, BK = 64, HALF = 128, HTB = HALF * BK * 2, STAGE_BYTES = 8 * HTB, NXCD = 8, WGM = 4;
__host__ __device__ __forceinline__ int lds_byte(int r, int c) { const int st = (r >> 4) * 2 + (c >> 5), rr = r & 15, cc = c & 31, ob = rr * 64 + cc * 2; return st * 1024 + (ob ^ (((ob >> 9) & 1) << 5)); }
__host__ __device__ __forceinline__ void stage_rc(int b, int& R, int& C) { const int st = b / 1024, sb = b % 1024, swz = sb ^ (((sb >> 9) & 1) << 5); R = (st >> 1) * 16 + swz / 64; C = (st & 1) * 32 + (swz % 64) / 2; }
struct Unit { int pm, pn; };
struct Gemm { const bf16_t* A; const bf16_t* Bt; int M, N, K; int nNr = 0; };
struct StaticOrder {
    int nM, nN, nwg, G, c, split_from;
    __device__ void init(int M, int N, int G_, int c_) { nM = M / BM; nN = N / BM; nwg = nM * nN; G = G_; c = c_; split_from = 0x7fffffff; }
    __device__ bool next(int i, Unit& u) const {
        long L = (long)i * G + c; int kh = 0;
        if (L >= split_from) { const long h = L - split_from; L = split_from + (h >> 1); kh = 1 + (int)(h & 1); }
        if (L >= nwg) return false;
        int wgid = (int)L; { const int q = nwg / NXCD, r = nwg % NXCD, xcd = wgid % NXCD, off = wgid / NXCD; wgid = (xcd < r ? xcd * (q + 1) : r * (q + 1) + (xcd - r) * q) + off; }
        const int nig = WGM * nN, gid = wgid / nig, fm = gid * WGM, gsz = (nM - fm) < WGM ? (nM - fm) : WGM;
        u.pm = fm + ((wgid % nig) % gsz); u.pn = (wgid % nig) / gsz + kh * nN; return true;
    }
};
template <class Epi>
__device__ __forceinline__ void gemm_phase(LAS unsigned char* lds, const Gemm g, const StaticOrder& S, const Epi& E) {
    const int tid = threadIdx.x, wid = __builtin_amdgcn_readfirstlane(tid >> 6), lane = tid & 63, wr = wid >> 2, wc = wid & 3, fr = lane & 15, fq = lane >> 4;
    int K_ = g.K; asm volatile("" : "+s"(K_));
    const int K = K_, nt = K / BK, nNr = g.nNr;
    const size_t khalf = (size_t)K;
#define PG8_KH(u) (nNr ? (u).pn / nNr : 0)
#define PG8_UA(u) ((const char*)g.A + (size_t)(u).pm * tstep + (PG8_KH(u) == 2 ? khalf : (size_t)0))
#define PG8_UB(u) ((const char*)g.Bt + (size_t)((u).pn - PG8_KH(u) * nNr) * tstep + (PG8_KH(u) == 2 ? khalf : (size_t)0))
#define PG8_NT(u) (PG8_KH(u) ? nt / 2 : nt)
    unsigned voffA[2], voffB[2];
#pragma unroll
    for (int i = 0; i < 2; ++i) { int R, C; stage_rc(tid * 16 + i * 8192, R, C); voffA[i] = (unsigned)(R * K + C) * 2u; voffB[i] = voffA[i]; }
    const size_t kstep = (size_t)(BK * 2);
    const size_t hstep = (size_t)HALF * K * 2;
    const size_t tstep = 2 * hstep;
    const unsigned ldsw = (unsigned)wid * 1024u;
    const int aoff = lds_byte(wr * 64 + fr, fq * 8), boff = lds_byte(wc * 32 + fr, fq * 8);
#define PG8_SA(b, h) (((b) * 2 + (h)) * HTB)
#define PG8_SB(b, h) ((4 + (b) * 2 + (h)) * HTB)
#define PG8_STAGE(bufoff, gbase, voff) do { _Pragma("unroll") for (int _i = 0; _i < 2; ++_i) \
        __builtin_amdgcn_global_load_lds((const unsigned*)((const char*)(gbase) + (voff)[_i]), (LAS unsigned*)(lds + (bufoff) + ldsw + _i * 8192), 16, 0, 0); } while (0)
#define PG8_LDA(dst, b, h) do { _Pragma("unroll") for (int m = 0; m < 4; ++m) _Pragma("unroll") for (int k = 0; k < 2; ++k) dst[m][k] = *(const LAS bf16x8*)(lds + PG8_SA(b, h) + aoff + m * 2048 + k * 1024); } while (0)
#define PG8_LDB(dst, b, h) do { _Pragma("unroll") for (int n = 0; n < 2; ++n) _Pragma("unroll") for (int k = 0; k < 2; ++k) dst[n][k] = *(const LAS bf16x8*)(lds + PG8_SB(b, h) + boff + n * 2048 + k * 1024); } while (0)
#define PG8_MMA(ai, bj, At, Bt) do { __builtin_amdgcn_s_setprio(1); _Pragma("unroll") for (int m = 0; m < 4; ++m) _Pragma("unroll") for (int n = 0; n < 2; ++n) _Pragma("unroll") for (int k = 0; k < 2; ++k) \
        acc[ai][bj][m][n] = __builtin_amdgcn_mfma_f32_16x16x32_bf16(Bt[n][k], At[m][k], acc[ai][bj][m][n], 0, 0, 0); __builtin_amdgcn_s_setprio(0); } while (0)
#define PG8_WAIT_V(n) asm volatile("s_waitcnt vmcnt(" #n ")" ::: "memory")
#define PG8_WAIT_L(n) asm volatile("s_waitcnt lgkmcnt(" #n ")" ::: "memory")
#define PG8_BAR __builtin_amdgcn_s_barrier()
#define PG8_SCHED __builtin_amdgcn_sched_barrier(0)
    Unit cur, nxt; int ui = 0;
    if (!S.next(0, cur)) return;
    f32x4 acc[2][2][4][2];
#pragma unroll
    for (int a = 0; a < 2; ++a)
#pragma unroll
        for (int b = 0; b < 2; ++b)
#pragma unroll
            for (int m = 0; m < 4; ++m)
#pragma unroll
                for (int n = 0; n < 2; ++n) acc[a][b][m][n] = (f32x4){0.f, 0.f, 0.f, 0.f};
    bf16x8 At[4][2], B0[2][2], B1[2][2];
    const char* cA = PG8_UA(cur); const char* cB = PG8_UB(cur); int cnt = PG8_NT(cur);
    PG8_STAGE(PG8_SB(0, 0), cB, voffB); PG8_STAGE(PG8_SA(0, 0), cA, voffA); PG8_STAGE(PG8_SB(0, 1), cB + hstep, voffB); PG8_STAGE(PG8_SA(0, 1), cA + hstep, voffA);
    if (wr == 1) PG8_BAR;
    PG8_WAIT_V(4); PG8_BAR;
    PG8_STAGE(PG8_SB(1, 0), cB + kstep, voffB); PG8_STAGE(PG8_SA(1, 0), cA + kstep, voffA); PG8_STAGE(PG8_SB(1, 1), cB + hstep + kstep, voffB);
    PG8_WAIT_V(6); PG8_BAR;
    for (;;) {
        const bool has_next = S.next(ui + 1, nxt);
        const char* nA = has_next ? PG8_UA(nxt) : cA; const char* nB = has_next ? PG8_UB(nxt) : cB;
        for (int t = 0; t < cnt; t += 2) {
            const bool last = (t == cnt - 2);
            const char* a1 = cA + (size_t)(t + 1) * kstep;
            const char* a2 = last ? nA : cA + (size_t)(t + 2) * kstep; const char* b2 = last ? nB : cB + (size_t)(t + 2) * kstep;
            const char* a3 = a2 + kstep; const char* b3 = b2 + kstep;
            PG8_LDB(B0, 0, 0); PG8_SCHED; PG8_LDA(At, 0, 0); PG8_STAGE(PG8_SA(1, 1), a1 + hstep, voffA);
            PG8_WAIT_L(8); PG8_BAR; PG8_WAIT_L(0); PG8_MMA(0, 0, At, B0); PG8_BAR; PG8_SCHED;
            PG8_LDB(B1, 0, 1); PG8_STAGE(PG8_SB(0, 0), b2, voffB);
            PG8_BAR; PG8_WAIT_L(0); PG8_MMA(0, 1, At, B1); PG8_BAR;
            PG8_LDA(At, 0, 1); PG8_STAGE(PG8_SA(0, 0), a2, voffA);
            PG8_BAR; PG8_WAIT_L(0); PG8_MMA(1, 0, At, B0); PG8_BAR; PG8_SCHED;
            PG8_STAGE(PG8_SB(0, 1), b2 + hstep, voffB);
            PG8_WAIT_V(6); PG8_BAR; PG8_MMA(1, 1, At, B1); PG8_BAR;
            PG8_LDB(B0, 1, 0); PG8_SCHED; PG8_LDA(At, 1, 0); PG8_STAGE(PG8_SA(0, 1), a2 + hstep, voffA);
            PG8_WAIT_L(8); PG8_BAR; PG8_WAIT_L(0); PG8_MMA(0, 0, At, B0); PG8_BAR; PG8_SCHED;
            PG8_LDB(B1, 1, 1); PG8_STAGE(PG8_SB(1, 0), b3, voffB);
            PG8_BAR; PG8_WAIT_L(0); PG8_MMA(0, 1, At, B1); PG8_BAR;
            PG8_LDA(At, 1, 1); PG8_STAGE(PG8_SA(1, 0), a3, voffA);
            PG8_BAR; PG8_WAIT_L(0); PG8_MMA(1, 0, At, B0); PG8_BAR; PG8_SCHED;
            PG8_STAGE(PG8_SB(1, 1), b3 + hstep, voffB);
            PG8_WAIT_V(6); PG8_BAR; PG8_MMA(1, 1, At, B1); PG8_BAR;
        }
        E(acc, cur, wr, wc, fr, fq);
        if (!has_next) break;
#pragma unroll
        for (int a = 0; a < 2; ++a)
#pragma unroll
            for (int b = 0; b < 2; ++b)
#pragma unroll
                for (int m = 0; m < 4; ++m)
#pragma unroll
                    for (int n = 0; n < 2; ++n) acc[a][b][m][n] = (f32x4){0.f, 0.f, 0.f, 0.f};
        cur = nxt; cA = nA; cB = nB; cnt = PG8_NT(cur); ++ui;
    }
    PG8_WAIT_V(0);
    if (wr == 0) PG8_BAR;
    PG8_BAR;
#undef PG8_KH
#undef PG8_UA
#undef PG8_UB
#undef PG8_NT
#undef PG8_SA
#undef PG8_SB
#undef PG8_STAGE
#undef PG8_LDA
#undef PG8_LDB
#undef PG8_MMA
#undef PG8_WAIT_V
#undef PG8_WAIT_L
#undef PG8_BAR
#undef PG8_SCHED
}
__device__ __forceinline__ int opaque_i(int v) { asm volatile("" : "+v"(v)); return v; }
template <class F> struct EpiEach {
    F f; bf16_t* out; int ld, ncols;
    __device__ __forceinline__ void operator()(const f32x4 (&acc)[2][2][4][2], const Unit& u, int wr, int wc, int fr, int fq) const {
        const int row0 = u.pm * BM + wr * 64 + fr, col0 = u.pn * BM + wc * 32 + 8 * fq;
#pragma unroll
        for (int ai = 0; ai < 2; ++ai)
#pragma unroll
            for (int m = 0; m < 4; ++m) { const int row = opaque_i(row0 + ai * HALF + m * 16);
#pragma unroll
                for (int bj = 0; bj < 2; ++bj) { const int col = col0 + bj * HALF;
                    if (col < ncols) { const f32x4 lo = f(row, col, acc[ai][bj][m][0]), hi = f(row, col + 4, acc[ai][bj][m][1]);
                        *(u32x4*)(out + (size_t)row * ld + col) = (u32x4){cvtpk(lo[0], lo[1]), cvtpk(lo[2], lo[3]), cvtpk(hi[0], hi[1]), cvtpk(hi[2], hi[3])}; } }
                __builtin_amdgcn_sched_barrier(0); }
    }
};
struct EpiSwiglu {
    bf16_t* act;
    __device__ __forceinline__ void operator()(const f32x4 (&acc)[2][2][4][2], const Unit& u, int wr, int wc, int fr, int fq) const {
        const int row0 = u.pm * BM + wr * 64 + fr, col0 = u.pn * HALF + wc * 32 + 8 * fq;
#pragma unroll
        for (int ai = 0; ai < 2; ++ai)
#pragma unroll
            for (int m = 0; m < 4; ++m) { const int row = opaque_i(row0 + ai * HALF + m * 16); float o[8];
#pragma unroll
                for (int n = 0; n < 2; ++n) { const f32x4 gt = acc[ai][0][m][n], up = acc[ai][1][m][n];
#pragma unroll
                    for (int j = 0; j < 4; ++j) o[4 * n + j] = gt[j] * sigmoidf_(gt[j]) * up[j]; }
                *(u32x4*)(act + (size_t)row * DFF + col0) = (u32x4){cvtpk(o[0], o[1]), cvtpk(o[2], o[3]), cvtpk(o[4], o[5]), cvtpk(o[6], o[7])};
                __builtin_amdgcn_sched_barrier(0); }
    }
};
}

struct EpiLora {
    float* dec; bf16_t* ab; bf16_t* gb; const float *w0_f, *w0_b, *a0_f, *a0_b;
    __device__ __forceinline__ void operator()(const f32x4 (&acc)[2][2][4][2], const pg8::Unit& u, int wr, int wc, int fr, int fq) const {
        const int kind = u.pn >> 2, row0 = u.pm * 256 + wr * 64 + fr, c0 = (u.pn & 3) * 256 + wc * 32 + 8 * fq;
        if (kind < 2) {
            const float* w0 = (kind ? w0_b : w0_f) + c0; float* d = dec + (size_t)kind * T * 1024 + c0;
            f32x4 w[2][2];
#pragma unroll
            for (int bj = 0; bj < 2; ++bj)
#pragma unroll
                for (int n = 0; n < 2; ++n) w[bj][n] = *(const f32x4*)(w0 + bj * 128 + n * 4);
#pragma unroll
            for (int ai = 0; ai < 2; ++ai)
#pragma unroll
                for (int m = 0; m < 4; ++m) { const int row = pg8::opaque_i(row0 + ai * 128 + m * 16);
#pragma unroll
                    for (int bj = 0; bj < 2; ++bj)
#pragma unroll
                        for (int n = 0; n < 2; ++n) { const f32x4 v = acc[ai][bj][m][n]; f32x4 o;
#pragma unroll
                            for (int j = 0; j < 4; ++j) o[j] = __expf(-0.6065306597126334f * sigmoidf_(w[bj][n][j] + v[j]));
                            *(f32x4*)(d + (size_t)row * 1024 + bj * 128 + n * 4) = o; }
                    __builtin_amdgcn_sched_barrier(0); }
        } else if (kind < 4) {
            const float* a0 = (kind == 3 ? a0_b : a0_f) + c0; bf16_t* d = ab + (size_t)(kind - 2) * ADS + c0;
            f32x4 w[2][2];
#pragma unroll
            for (int bj = 0; bj < 2; ++bj)
#pragma unroll
                for (int n = 0; n < 2; ++n) w[bj][n] = *(const f32x4*)(a0 + bj * 128 + n * 4);
#pragma unroll
            for (int ai = 0; ai < 2; ++ai)
#pragma unroll
                for (int m = 0; m < 4; ++m) { const int row = pg8::opaque_i(row0 + ai * 128 + m * 16);
#pragma unroll
                    for (int bj = 0; bj < 2; ++bj) { const f32x4 v0 = acc[ai][bj][m][0], v1 = acc[ai][bj][m][1], x0 = w[bj][0], x1 = w[bj][1];
                        *(u32x4*)(d + (size_t)row * 1024 + bj * 128) = (u32x4){cvtpk(sigmoidf_(x0[0] + v0[0]), sigmoidf_(x0[1] + v0[1])), cvtpk(sigmoidf_(x0[2] + v0[2]), sigmoidf_(x0[3] + v0[3])),
                                                                                cvtpk(sigmoidf_(x1[0] + v1[0]), sigmoidf_(x1[1] + v1[1])), cvtpk(sigmoidf_(x1[2] + v1[2]), sigmoidf_(x1[3] + v1[3]))}; }
                    __builtin_amdgcn_sched_barrier(0); }
        } else {
            bf16_t* d = gb + c0;
#pragma unroll
            for (int ai = 0; ai < 2; ++ai)
#pragma unroll
                for (int m = 0; m < 4; ++m) { const int row = pg8::opaque_i(row0 + ai * 128 + m * 16);
#pragma unroll
                    for (int bj = 0; bj < 2; ++bj) { const f32x4 v0 = acc[ai][bj][m][0], v1 = acc[ai][bj][m][1];
                        *(u32x4*)(d + (size_t)row * 1024 + bj * 128) = (u32x4){cvtpk(v0[0], v0[1]), cvtpk(v0[2], v0[3]), cvtpk(v1[0], v1[1]), cvtpk(v1[2], v1[3])}; }
                    __builtin_amdgcn_sched_barrier(0); }
        }
    }
};

__device__ __forceinline__ int down_unit_index(int pm, int pn) { const int wgid = (pm / pg8::WGM) * (pg8::WGM * 8) + pn * pg8::WGM + (pm % pg8::WGM); return (wgid % 80) * 8 + wgid / 80; }
struct EpiDown {
    const bf16_t* x1b; bf16_t* h2; bf16_t* part; const float* md; int split_from;
    __device__ __forceinline__ void operator()(const f32x4 (&acc)[2][2][4][2], const pg8::Unit& u, int wr, int wc, int fr, int fq) const {
        const int kh = u.pn >> 3, pn = u.pn & 7, row0 = u.pm * 256 + wr * 64 + fr, col0 = pn * 256 + wc * 32 + 8 * fq;
        bf16_t* pt = part + (size_t)(down_unit_index(u.pm, pn) - split_from) * 65536;
#pragma unroll
        for (int ai = 0; ai < 2; ++ai)
#pragma unroll
            for (int m = 0; m < 4; ++m) { const int row = pg8::opaque_i(row0 + ai * 128 + m * 16); const float* mg = md + cond_of(row) * 12288 + 5 * 2048;
#pragma unroll
                for (int bj = 0; bj < 2; ++bj) { const int col = col0 + bj * 128;
                    const f32x4 g0 = *(const f32x4*)(mg + col), g1 = *(const f32x4*)(mg + col + 4);
                    f32x4 o0 = g0 * acc[ai][bj][m][0], o1 = g1 * acc[ai][bj][m][1];
                    if (kh < 2) { float x[8]; unpack8(*(const u32x4*)(x1b + (size_t)row * 2048 + col), x);
                        o0 += ALPHA * (f32x4){x[0], x[1], x[2], x[3]}; o1 += ALPHA * (f32x4){x[4], x[5], x[6], x[7]};
                        *(u32x4*)(h2 + (size_t)row * 2048 + col) = (u32x4){cvtpk(o0[0], o0[1]), cvtpk(o0[2], o0[3]), cvtpk(o1[0], o1[1]), cvtpk(o1[2], o1[3])}; }
                    else *(u32x4*)(pt + (row & 255) * 256 + (col & 255)) = (u32x4){cvtpk(o0[0], o0[1]), cvtpk(o0[2], o0[3]), cvtpk(o1[0], o1[1]), cvtpk(o1[2], o1[3])}; }
                __builtin_amdgcn_sched_barrier(0); }
    }
};

template <class F> __device__ __forceinline__ void run_gemm(LAS unsigned char* lds, const bf16_t* A, const bf16_t* Bt, int M, int N, int K, int rot, bf16_t* out, int ld, int ncols, F f) {
    pg8::Gemm g{A, Bt, M, N, K}; pg8::StaticOrder S; int c_ = (int)blockIdx.x + rot; if (c_ >= (int)gridDim.x) c_ -= (int)gridDim.x; S.init(M, N, (int)gridDim.x, c_);
    pg8::EpiEach<F> E{f, out, ld, ncols};
    pg8::gemm_phase(lds, g, S, E);
}

namespace att {
constexpr int NW = 8, QBLK = 32, KVBLK = 64;
constexpr float SCALE = 0.07216878364870322f;
constexpr float THR = 8.f;
constexpr int LDQ = 1536, LDKV = 2048, LDKR = 64, LDO = 2048;
constexpr int SHM_V = KVBLK * 128 * 2, SHM_K = KVBLK * 192 * 2;
#define KSWZ(row, colB) ((row) * 384 + ((colB) ^ (((row) & 7) << 4)))
#define SBAR() __builtin_amdgcn_sched_barrier(0)
__device__ __forceinline__ int crow(int r, int hi) { return (r & 3) + 8 * (r >> 2) + 4 * hi; }
__device__ __forceinline__ void partialSM(f32x16& p0, f32x16& p1, float& m_reg, float& mn, float& alpha) {
    constexpr float C = SCALE * 1.4426950408889634f;
    float pmax = p0[0];
#pragma unroll
    for (int r = 1; r < 16; ++r) pmax = fmaxf(pmax, p0[r]);
#pragma unroll
    for (int r = 0; r < 16; ++r) pmax = fmaxf(pmax, p1[r]);
    { auto rr = __builtin_amdgcn_permlane32_swap(__float_as_uint(pmax), __float_as_uint(pmax), false, false);
      pmax = fmaxf(__uint_as_float(rr[0]), __uint_as_float(rr[1])); }
    if (__builtin_expect(__all(pmax - m_reg <= THR / SCALE), 1)) { mn = m_reg; alpha = 1.f; }
    else { mn = fmaxf(m_reg, pmax); alpha = __builtin_amdgcn_exp2f((m_reg - mn) * C); m_reg = mn; }
    float mnC = -mn * C;
#pragma unroll
    for (int r = 0; r < 16; ++r) p0[r] = fmaf(p0[r], C, mnC);
#pragma unroll
    for (int r = 0; r < 16; ++r) p1[r] = fmaf(p1[r], C, mnC);
#pragma unroll
    for (int r = 0; r < 16; ++r) p0[r] = __builtin_amdgcn_exp2f(p0[r]);
}
__device__ __forceinline__ void finishSM(f32x16& p0, f32x16& p1, float alpha, float& l_reg, bf16x8& pa0, bf16x8& pa1, bf16x8& pa2, bf16x8& pa3) {
#pragma unroll
    for (int r = 0; r < 16; ++r) p1[r] = __builtin_amdgcn_exp2f(p1[r]);
    float ps = 0;
#pragma unroll
    for (int r = 0; r < 16; ++r) ps += p0[r];
#pragma unroll
    for (int r = 0; r < 16; ++r) ps += p1[r];
    { auto rr = __builtin_amdgcn_permlane32_swap(__float_as_uint(ps), __float_as_uint(ps), false, false);
      ps = __uint_as_float(rr[0]) + __uint_as_float(rr[1]); }
    l_reg = l_reg * alpha + ps;
#define PK4(P, BASE, OUT) do { unsigned a0 = cvtpk(P[BASE + 0], P[BASE + 1]), a1 = cvtpk(P[BASE + 2], P[BASE + 3]);   \
    unsigned b0 = cvtpk(P[BASE + 4], P[BASE + 5]), b1 = cvtpk(P[BASE + 6], P[BASE + 7]);                              \
    auto r0 = __builtin_amdgcn_permlane32_swap(a0, b0, false, false); auto r1 = __builtin_amdgcn_permlane32_swap(a1, b1, false, false); \
    u32x4 w = {r0[0], r1[0], r0[1], r1[1]}; OUT = *reinterpret_cast<bf16x8*>(&w); } while (0)
    PK4(p0, 0, pa0); PK4(p0, 8, pa1); PK4(p1, 0, pa2); PK4(p1, 8, pa3);
#undef PK4
}
__device__ __forceinline__ void qkt(f32x16& p0, f32x16& p1, const char* Ks, const bf16x8* qr, int r32, int hi) {
    p0 = f32x16{}; p1 = f32x16{};
#pragma unroll
    for (int d0 = 0; d0 < 12; ++d0) { int cb = (d0 * 16 + hi * 8) * 2;
        bf16x8 b0 = *reinterpret_cast<const bf16x8*>(Ks + KSWZ(r32, cb));
        bf16x8 b1 = *reinterpret_cast<const bf16x8*>(Ks + KSWZ(32 + r32, cb));
        p0 = __builtin_amdgcn_mfma_f32_32x32x16_bf16(b0, qr[d0], p0, 0, 0, 0);
        p1 = __builtin_amdgcn_mfma_f32_32x32x16_bf16(b1, qr[d0], p1, 0, 0, 0); }
}
__device__ __forceinline__ int v_st(int k, int c) { const int kk = (k & ~0xC) | ((k & 4) << 1) | ((k & 8) >> 1); return ((kk >> 3) * 4 + (c >> 5)) * 512 + ((kk & 7) * 32 + (c & 31)) * 2; }
__device__ __forceinline__ int v_rd_base(int lane) { return ((lane & 3) << 3) | (((lane >> 2) & 3) << 6) | (((lane >> 4) & 1) << 5) | (((lane >> 5) & 1) << 8); }
constexpr int v_rd_off(int d0, int ks, int half) { return d0 * 512 + ks * 4096 + half * 2048; }
template <int OFF> __device__ __forceinline__ s16x4 tr_read(int vb) {
    s16x4 r; asm volatile("ds_read_b64_tr_b16 %0, %1 offset:%2" : "=&v"(r) : "v"(vb), "i"(OFF) : "memory"); return r;
}
template <int D0> __device__ __forceinline__ void pv_one(f32x16& od, int vb, bf16x8 pa0, bf16x8 pa1, bf16x8 pa2, bf16x8 pa3) {
    const s16x4 l0 = tr_read<v_rd_off(D0, 0, 0)>(vb), h0 = tr_read<v_rd_off(D0, 0, 1)>(vb), l1 = tr_read<v_rd_off(D0, 1, 0)>(vb), h1 = tr_read<v_rd_off(D0, 1, 1)>(vb);
    const s16x4 l2 = tr_read<v_rd_off(D0, 2, 0)>(vb), h2 = tr_read<v_rd_off(D0, 2, 1)>(vb), l3 = tr_read<v_rd_off(D0, 3, 0)>(vb), h3 = tr_read<v_rd_off(D0, 3, 1)>(vb);
    asm volatile("s_waitcnt lgkmcnt(0)" ::: "memory"); SBAR();
#define PK(L, H) (bf16x8){L[0], L[1], L[2], L[3], H[0], H[1], H[2], H[3]}
    od = __builtin_amdgcn_mfma_f32_32x32x16_bf16(pa0, PK(l0, h0), od, 0, 0, 0);
    od = __builtin_amdgcn_mfma_f32_32x32x16_bf16(pa1, PK(l1, h1), od, 0, 0, 0);
    od = __builtin_amdgcn_mfma_f32_32x32x16_bf16(pa2, PK(l2, h2), od, 0, 0, 0);
    od = __builtin_amdgcn_mfma_f32_32x32x16_bf16(pa3, PK(l3, h3), od, 0, 0, 0);
#undef PK
}
__device__ __forceinline__ void pv_d0(f32x16* o, int vb, bf16x8 pa0, bf16x8 pa1, bf16x8 pa2, bf16x8 pa3) {
    pv_one<0>(o[0], vb, pa0, pa1, pa2, pa3); pv_one<1>(o[1], vb, pa0, pa1, pa2, pa3); pv_one<2>(o[2], vb, pa0, pa1, pa2, pa3); pv_one<3>(o[3], vb, pa0, pa1, pa2, pa3);
}
__device__ __forceinline__ void attn_body(const bf16_t* __restrict__ Qb, const bf16_t* __restrict__ Kh, const bf16_t* __restrict__ Vh, const bf16_t* __restrict__ KRh,
                                          bf16_t* __restrict__ Ob, int seq, char* lds) {
    const int tid = threadIdx.x, wid = tid >> 6, lane = tid & 63, r32 = lane & 31, hi = lane >> 5;
    char* V_lds = lds; char* K_lds = lds + 2 * SHM_V;
    float* ws = (float*)(lds + 2 * SHM_V + 2 * SHM_K) + wid * 64; float* li_l = ws; float* al_l = ws + 32;
    float m_reg = -1e30f, l_reg = 0; f32x16 o[4] = {}; bf16x8 qr[12];
    const bf16_t* Qw = Qb + (long)(wid * QBLK + r32) * LDQ + hi * 8;
#pragma unroll
    for (int d0 = 0; d0 < 12; ++d0) qr[d0] = *reinterpret_cast<const bf16x8*>(Qw + d0 * 16);
    const int sr = tid >> 4, sc = (tid & 15) * 8, vst0 = v_st(sr, sc), vst1 = v_st(32 + sr, sc);
    const int rr = tid >> 3, rc = (tid & 7) * 8;
    const int vb0 = (int)(uintptr_t)V_lds + v_rd_base(lane);
    struct { bf16x8 vs0, vs1, ks0, ks1, kr0; } sr_[1];
#define SLOAD(i, k0) do { sr_[i].vs0 = *(const bf16x8*)(&Vh[(long)((k0) + sr) * LDKV + sc]); sr_[i].vs1 = *(const bf16x8*)(&Vh[(long)((k0) + 32 + sr) * LDKV + sc]); \
    sr_[i].ks0 = *(const bf16x8*)(&Kh[(long)((k0) + sr) * LDKV + sc]); sr_[i].ks1 = *(const bf16x8*)(&Kh[(long)((k0) + 32 + sr) * LDKV + sc]); \
    sr_[i].kr0 = *(const bf16x8*)(&KRh[(long)((k0) + rr) * LDKR + rc]); } while (0)
#define SWRITE(b, i) do { *(bf16x8*)(V_lds + (b) * SHM_V + vst0) = sr_[i].vs0;          \
    *(bf16x8*)(V_lds + (b) * SHM_V + vst1) = sr_[i].vs1; int kc = sc * 2;               \
    *(bf16x8*)(K_lds + (b) * SHM_K + KSWZ(sr, kc)) = sr_[i].ks0;                       \
    *(bf16x8*)(K_lds + (b) * SHM_K + KSWZ(32 + sr, kc)) = sr_[i].ks1;                  \
    *(bf16x8*)(K_lds + (b) * SHM_K + KSWZ(rr, 256 + rc * 2)) = sr_[i].kr0; } while (0)
#define SWAIT() asm volatile("s_waitcnt vmcnt(0)" ::: "memory")
#define RESC(a) do { if (__any((a) < 1.f)) { if (hi == 0) al_l[r32] = (a); asm volatile("s_waitcnt lgkmcnt(0)" ::: "memory"); \
    _Pragma("unroll") for (int d = 0; d < 4; ++d) _Pragma("unroll") for (int r = 0; r < 16; ++r) o[d][r] *= al_l[crow(r, hi)]; } } while (0)
    f32x16 p0, p1; float mn, al; bf16x8 pa0, pa1, pa2, pa3; const int NT = seq / KVBLK;
    SLOAD(0, 0); SWAIT(); SWRITE(0, 0); __syncthreads();
    for (int j = 0; j < NT; ++j) {
        const int bsel = j & 1; const bool more = j + 1 < NT;
        SBAR(); qkt(p0, p1, K_lds + bsel * SHM_K, qr, r32, hi);
        partialSM(p0, p1, m_reg, mn, al);
        RESC(al); SBAR();
        if (more) SLOAD(0, (j + 1) * KVBLK);
        SBAR();
        finishSM(p0, p1, al, l_reg, pa0, pa1, pa2, pa3); SBAR();
        pv_d0(o, vb0 + bsel * SHM_V, pa0, pa1, pa2, pa3);
        if (more) { SWAIT(); SWRITE(bsel ^ 1, 0); }
        __syncthreads();
    }
    if (hi == 0) li_l[r32] = l_reg; asm volatile("s_waitcnt lgkmcnt(0)" ::: "memory");
    float rli[16];
#pragma unroll
    for (int r = 0; r < 16; ++r) rli[r] = __builtin_amdgcn_rcpf(li_l[crow(r, hi)]);
    bf16_t* Ow = Ob + (long)(wid * QBLK) * LDO;
#pragma unroll
    for (int r = 0; r < 16; ++r) { int orow = crow(r, hi);
#pragma unroll
        for (int d0 = 0; d0 < 4; ++d0) Ow[(long)orow * LDO + d0 * 32 + r32] = f2bf(o[d0][r] * rli[r]); }
    __syncthreads();
#undef SLOAD
#undef SWRITE
#undef SWAIT
#undef RESC
}
}

template <class F> __device__ __forceinline__ void conv_weight(bf16_t* dst, int N, int K, F src, int b0 = 0, int nb = 0) {
    extern __shared__ __attribute__((aligned(16))) unsigned char cw_shm[];
    const int nkb = K / 64, items = (N / 64) * nkb;
    if (nb == 0) nb = gridDim.x;
    if ((int)blockIdx.x < b0) return;
    int tid_ = threadIdx.x; asm volatile("" : "+v"(tid_));
#pragma unroll 1
    for (int it = blockIdx.x - b0; it < items; it += nb) {
        const int tid = tid_, nl = tid & 63, kc = tid >> 6;
        const int n0 = (it / nkb) * 64, k0 = (it % nkb) * 64, n = n0 + nl;
        const int rho = n & 31, ns = (n & ~31) + 8 * ((rho & 15) >> 2) + 4 * (rho >> 4) + (rho & 3);
        u32x4 w;
        { float f[8];
#pragma unroll
          for (int i = 0; i < 8; ++i) f[i] = src(ns, k0 + kc * 8 + i);
          w = pack8(f); }
        __builtin_amdgcn_s_waitcnt(0xc07f); __builtin_amdgcn_s_barrier();
        *(u32x4*)(cw_shm + nl * 144 + kc * 16) = w;
        __builtin_amdgcn_s_waitcnt(0xc07f); __builtin_amdgcn_s_barrier();
        const int rr = tid >> 3, cc = tid & 7;
        *(u32x4*)(dst + (size_t)(n0 + rr) * K + k0 + cc * 8) = *(const u32x4*)(cw_shm + rr * 144 + cc * 16);
    }
    __syncthreads();
}

template <int I> __device__ __forceinline__ void fmac_bc(float& acc, float x, float y) {
    asm volatile("v_fmac_f32_dpp %0, %1, %2 row_newbcast:%3 row_mask:0xf bank_mask:0xf" : "+v"(acc) : "v"(x), "v"(y), "n"(I));
}
template <int I> __device__ __forceinline__ float mul_bc(float x, float y) {
    float r; asm volatile("v_mul_f32_dpp %0, %1, %2 row_newbcast:%3 row_mask:0xf bank_mask:0xf" : "=v"(r) : "v"(x), "v"(y), "n"(I)); return r;
}
__device__ __forceinline__ float red4rows(float x) {
    auto r = __builtin_amdgcn_permlane16_swap(__float_as_uint(x), __float_as_uint(x), false, false);
    float s = __uint_as_float(r[0]) + __uint_as_float(r[1]);
    auto q = __builtin_amdgcn_permlane32_swap(__float_as_uint(s), __float_as_uint(s), false, false);
    return __uint_as_float(q[0]) + __uint_as_float(q[1]);
}
template <int I> struct ScanStep {
    static __device__ __forceinline__ void sa(const float (&S)[16], float kk, float& a0, float& a1, float& a2, float& a3) {
        if ((I & 3) == 0) fmac_bc<I>(a0, kk, S[I]); else if ((I & 3) == 1) fmac_bc<I>(a1, kk, S[I]); else if ((I & 3) == 2) fmac_bc<I>(a2, kk, S[I]); else fmac_bc<I>(a3, kk, S[I]);
        ScanStep<I + 1>::sa(S, kk, a0, a1, a2, a3);
    }
    static __device__ __forceinline__ void p1(float (&t)[16], float kd, float vv) { t[I] = mul_bc<I>(kd, vv); ScanStep<I + 1>::p1(t, kd, vv); }
    static __device__ __forceinline__ void p2(float (&t)[16], float b, float sa) { fmac_bc<I>(t[I], b, sa); ScanStep<I + 1>::p2(t, b, sa); }
    static __device__ __forceinline__ void p3(float (&t)[16], float w, const float (&S)[16]) { fmac_bc<I>(t[I], w, S[I]); ScanStep<I + 1>::p3(t, w, S); }
    static __device__ __forceinline__ void p4(const float (&t)[16], float r, float& y0, float& y1, float& y2, float& y3) {
        if ((I & 3) == 0) fmac_bc<I>(y0, r, t[I]); else if ((I & 3) == 1) fmac_bc<I>(y1, r, t[I]); else if ((I & 3) == 2) fmac_bc<I>(y2, r, t[I]); else fmac_bc<I>(y3, r, t[I]);
        ScanStep<I + 1>::p4(t, r, y0, y1, y2, y3);
    }
};
template <> struct ScanStep<16> {
    static __device__ __forceinline__ void sa(const float (&)[16], float, float&, float&, float&, float&) {}
    static __device__ __forceinline__ void p1(float (&)[16], float, float) {}
    static __device__ __forceinline__ void p2(float (&)[16], float, float) {}
    static __device__ __forceinline__ void p3(float (&)[16], float, const float (&)[16]) {}
    static __device__ __forceinline__ void p4(const float (&)[16], float, float&, float&, float&, float&) {}
};
struct ScanRaw { bf16_t r, k, a, v; float w, rk; };
__device__ __forceinline__ void scan_one(const Params& p, int base, int N, int h, int dir, const float* s0, float* s_out, int wv, int lane) {
    const bf16_t* rb = (const bf16_t*)(p.ws + O_R); const bf16_t* kb = (const bf16_t*)(p.ws + O_K); const bf16_t* vb = (const bf16_t*)(p.ws + O_V);
    const bf16_t* ab = (const bf16_t*)(p.ws + O_A) + (size_t)dir * ADS; const float* wb = p.out + (size_t)dir * T * 1024; const float* rkb = (const float*)(p.ws + O_RK);
    bf16_t* yb = (bf16_t*)(p.ws + (dir ? O_YB : O_YF));
    const int kq = lane >> 4, vs = lane & 15, vrow = 16 * wv + vs, ch = h * 64 + lane;
    const float kkc = p.k_k[ch], kac = p.k_a[ch];
    float S[16];
#pragma unroll
    for (int i = 0; i < 16; ++i) S[i] = s0 ? s0[vrow * 64 + kq * 16 + i] : 0.f;
    const int step = dir ? -1 : 1; int row = base + (dir ? N - 1 : 0);
    constexpr int U = 8;
    ScanRaw cur[U], nxt[U];
#define SC_LOAD(dst, row0) do { _Pragma("unroll") for (int s = 0; s < U; ++s) { const size_t ro = (size_t)((row0) + s * step); \
        dst[s].r = rb[ro * 1024 + ch]; dst[s].k = kb[ro * 1024 + ch]; dst[s].a = ab[ro * 1024 + ch]; dst[s].v = vb[ro * 1024 + h * 64 + vrow]; \
        dst[s].w = wb[ro * 1024 + ch]; dst[s].rk = rkb[ro * 16 + h]; } } while (0)
    SC_LOAD(cur, row);
    __builtin_amdgcn_s_waitcnt(0x0F70);
    for (int blk = 0; blk < N / U; ++blk) {
        const bool more = (blk + 1 < N / U);
        if (more) SC_LOAD(nxt, row + U * step);
#pragma unroll
        for (int s = 0; s < U; ++s) {
            const float kf = bf2f(cur[s].k), af = bf2f(cur[s].a);
            float kk = kf * kkc * cur[s].rk, bb = kk * af, kd = kf * (1.f + (af - 1.f) * kac), rr = bf2f(cur[s].r), ww = cur[s].w;
            const float vv = bf2f(cur[s].v);
            asm volatile("s_nop 1" : "+v"(kk), "+v"(bb), "+v"(kd), "+v"(rr), "+v"(ww));
            float a0 = 0.f, a1 = 0.f, a2 = 0.f, a3 = 0.f;
            ScanStep<0>::sa(S, kk, a0, a1, a2, a3);
            const float sa = -red4rows((a0 + a1) + (a2 + a3));
            float y0 = 0.f, y1 = 0.f, y2 = 0.f, y3 = 0.f;
            float tt[16];
            ScanStep<0>::p1(tt, kd, vv); ScanStep<0>::p2(tt, bb, sa); ScanStep<0>::p3(tt, ww, S); ScanStep<0>::p4(tt, rr, y0, y1, y2, y3);
#pragma unroll
            for (int i = 0; i < 16; ++i) S[i] = tt[i];
            const float y = red4rows((y0 + y1) + (y2 + y3));
            if (kq == 0) yb[(size_t)(row + s * step) * 1024 + h * 64 + vrow] = f2bf(y);
        }
        row += U * step;
        if (more) {
#pragma unroll
            for (int s = 0; s < U; ++s) cur[s] = nxt[s];
        }
    }
#undef SC_LOAD
    if (s_out) {
#pragma unroll
        for (int i = 0; i < 16; ++i) s_out[vrow * 64 + kq * 16 + i] = S[i];
    }
}

template <int CTRL> __device__ __forceinline__ float dpp_mov(float x) { return __builtin_bit_cast(float, __builtin_amdgcn_update_dpp(0, __builtin_bit_cast(int, x), CTRL, 0xf, 0xf, true)); }
__device__ __forceinline__ float wave_sum_dpp(float x) {
    x += dpp_mov<0xB1>(x); x += dpp_mov<0x4E>(x); x += dpp_mov<0x141>(x); x += dpp_mov<0x140>(x);
    return red4rows(x);
}
namespace cs {
constexpr int TSB = 144, ARR = 16 * TSB;
constexpr int OFF_KK = 0, OFF_R = ARR, OFF_B = 2 * ARR, OFF_KD = 3 * ARR, OFF_BT = 4 * ARR, OFF_KDT = OFF_BT + 2048, OFF_G = OFF_KDT + 2048, WAVE_LDS = OFF_G + 256;
static_assert(8 * WAVE_LDS <= 131072, "scan LDS");
__device__ __forceinline__ bf16x8 mk8(u32x2 lo, u32x2 hi) { u32x4 w = {lo[0], lo[1], hi[0], hi[1]}; return __builtin_bit_cast(bf16x8, w); }
__device__ __forceinline__ bf16x8 mk8u(unsigned a, unsigned b, unsigned c, unsigned d) { u32x4 w = {a, b, c, d}; return __builtin_bit_cast(bf16x8, w); }
__device__ __forceinline__ bf16x8 frag_tm(const char* lds, int off, int s, int c16, int g) {
    const char* p = lds + off + c16 * TSB + s * 64 + g * 8; return mk8(*(const u32x2*)p, *(const u32x2*)(p + 32));
}
template <int TT> struct Solve {
    static __device__ __forceinline__ void run(float (&u)[4], const float (&abn)[4]) {
        constexpr int gt = TT >> 2, jt = TT & 3;
        const unsigned x = __float_as_uint(u[jt]);
        auto r16 = __builtin_amdgcn_permlane16_swap(x, x, false, false); const unsigned a = (gt & 1) ? r16[1] : r16[0];
        auto r32 = __builtin_amdgcn_permlane32_swap(a, a, false, false); const float ut = __uint_as_float((gt & 2) ? r32[1] : r32[0]);
        fmac_bc<TT>(u[0], abn[0], ut); fmac_bc<TT>(u[1], abn[1], ut); fmac_bc<TT>(u[2], abn[2], ut); fmac_bc<TT>(u[3], abn[3], ut);
        Solve<TT + 1>::run(u, abn);
    }
};
template <> struct Solve<15> { static __device__ __forceinline__ void run(float (&)[4], const float (&)[4]) {} };
template <int GB> struct BlockSolve {
    static __device__ __forceinline__ void run(float (&u)[4], const float (&abn)[4], unsigned pA0, unsigned pA1, int c16, int g) {
        float d1 = g == GB ? abn[1] : 0.f, d2 = g == GB ? abn[2] : 0.f, d3 = g == GB ? abn[3] : 0.f;
        asm volatile("s_nop 1" : "+v"(d1), "+v"(d2), "+v"(d3));
        fmac_bc<4 * GB + 0>(u[1], d1, u[0]);
        fmac_bc<4 * GB + 0>(u[2], d2, u[0]); fmac_bc<4 * GB + 1>(u[2], d2, u[1]);
        fmac_bc<4 * GB + 0>(u[3], d3, u[0]); fmac_bc<4 * GB + 1>(u[3], d3, u[1]); fmac_bc<4 * GB + 2>(u[3], d3, u[2]);
        if (GB < 3) {
            const bool on = (g == GB) && (c16 >= 4 * GB + 4);
            const bf16x8 A = mk8u(on ? pA0 : 0u, on ? pA1 : 0u, 0u, 0u), B = mk8u(cvtpk(u[0], u[1]), cvtpk(u[2], u[3]), 0u, 0u);
            f32x4 uu = {u[0], u[1], u[2], u[3]};
            uu = __builtin_amdgcn_mfma_f32_16x16x32_bf16(A, B, uu, 0, 0, 0);
            u[0] = uu[0]; u[1] = uu[1]; u[2] = uu[2]; u[3] = uu[3];
            BlockSolve<GB + 1>::run(u, abn, pA0, pA1, c16, g);
        }
    }
};
template <> struct BlockSolve<4> { static __device__ __forceinline__ void run(float (&)[4], const float (&)[4], unsigned, unsigned, int, int) {} };
struct Raw { bf16_t r[4], k[4], a[4]; float wo[4]; float w[16]; float rk; bf16_t v[4]; };
constexpr int GROUP_LDS = 2 * WAVE_LDS;
__device__ __forceinline__ void scan_chunked(const Params& p, char* glds, volatile LAS unsigned* cnt, unsigned& gc, int base, int N, int h, int dir, const float* s0, float* s_out, int wv, int lane) {
    const bf16_t* rb = (const bf16_t*)(p.ws + O_R) + h * 64; const bf16_t* kb = (const bf16_t*)(p.ws + O_K) + h * 64; const bf16_t* vb = (const bf16_t*)(p.ws + O_V) + h * 64;
    const bf16_t* ab = (const bf16_t*)(p.ws + O_A) + (size_t)dir * ADS + h * 64; const float* wb = p.out + (size_t)dir * T * 1024 + h * 64; const float* rkb = (const float*)(p.ws + O_RK) + h;
    bf16_t* yb = (bf16_t*)(p.ws + (dir ? O_YB : O_YF));
    const int c16 = lane & 15, g = lane >> 4, v0 = 16 * wv, ch = h * 64 + lane;
    const float kkc = p.k_k[ch], kac = p.k_a[ch], rkc = p.r_k[ch];
    float* bon = (float*)(p.ws + O_BON) + (size_t)dir * T * 16 + h;
    f32x4 ST[4];
#pragma unroll
    for (int tl = 0; tl < 4; ++tl) ST[tl] = s0 ? *(const f32x4*)(s0 + (v0 + c16) * 64 + 16 * tl + 4 * g) : (f32x4){0.f, 0.f, 0.f, 0.f};
    const int step = dir ? -1 : 1; int row = base + (dir ? N - 1 : 0);
    Raw raw; const unsigned lo2 = (unsigned)lane * 2u, lo4 = (unsigned)lane * 4u;
#define CS_LOAD(row0) do { _Pragma("unroll") for (int t = 0; t < 16; ++t) { const size_t ro = (size_t)__builtin_amdgcn_readfirstlane((row0) + t * step) * 1024; \
        raw.w[t] = *(const float*)((const char*)(wb + ro) + lo4); } \
        _Pragma("unroll") for (int tt = 0; tt < 4; ++tt) { const size_t ro = (size_t)__builtin_amdgcn_readfirstlane((row0) + (4 * wv + tt) * step) * 1024; \
        raw.r[tt] = *(const bf16_t*)((const char*)(rb + ro) + lo2); raw.k[tt] = *(const bf16_t*)((const char*)(kb + ro) + lo2); \
        raw.a[tt] = *(const bf16_t*)((const char*)(ab + ro) + lo2); raw.wo[tt] = *(const float*)((const char*)(wb + ro) + lo4); } \
        raw.rk = rkb[(size_t)((row0) + c16 * step) * 16]; \
        _Pragma("unroll") for (int jj = 0; jj < 4; ++jj) raw.v[jj] = vb[(size_t)((row0) + (4 * g + jj) * step) * 1024 + v0 + c16]; } while (0)
    CS_LOAD(row);
    const int nch = N >> 4;
    for (int c = 0; c < nch; ++c, ++gc) {
        char* lds = glds + (gc & 1u) * WAVE_LDS;
        const float q0 = (raw.w[0] * raw.w[1]) * (raw.w[2] * raw.w[3]), q1 = (raw.w[4] * raw.w[5]) * (raw.w[6] * raw.w[7]);
        const float q2 = (raw.w[8] * raw.w[9]) * (raw.w[10] * raw.w[11]), q3 = (raw.w[12] * raw.w[13]) * (raw.w[14] * raw.w[15]);
        const float q01 = q0 * q1, G15 = q01 * (q2 * q3);
        float G = wv == 0 ? 1.f : (wv == 1 ? q0 : (wv == 2 ? q01 : q01 * q2));
        float bh[4], kdh[4], bterm[4];
#pragma unroll
        for (int tt = 0; tt < 4; ++tt) {
            const float kf = bf2f(raw.k[tt]), af = bf2f(raw.a[tt]), rf = bf2f(raw.r[tt]);
            const float rkt = __builtin_bit_cast(float, __builtin_amdgcn_readlane(__builtin_bit_cast(int, raw.rk), 4 * wv + tt));
            const float kk = kf * kkc * rkt, bb = kk * af, kd = kf * (1.f + (af - 1.f) * kac);
            bterm[tt] = rf * kd * rkc;
            const float Gp = G; G *= raw.wo[tt]; const float iG = __builtin_amdgcn_rcpf(G);
            bh[tt] = bb * iG; kdh[tt] = kd * iG;
            const unsigned p1 = cvtpk(kk * Gp, rf * G), p2 = cvtpk(bh[tt], kdh[tt]);
            char* tp = lds + (4 * wv + tt) * TSB + lane * 2;
            *(bf16_t*)(tp + OFF_KK) = (bf16_t)p1; *(bf16_t*)(tp + OFF_R) = (bf16_t)(p1 >> 16);
            *(bf16_t*)(tp + OFF_B) = (bf16_t)p2; *(bf16_t*)(tp + OFF_KD) = (bf16_t)(p2 >> 16);
        }
        *(u32x2*)(lds + OFF_BT + lane * 32 + wv * 8) = (u32x2){cvtpk(bh[0] * G15, bh[1] * G15), cvtpk(bh[2] * G15, bh[3] * G15)};
        *(u32x2*)(lds + OFF_KDT + lane * 32 + wv * 8) = (u32x2){cvtpk(kdh[0] * G15, kdh[1] * G15), cvtpk(kdh[2] * G15, kdh[3] * G15)};
        if (wv == 0) *(float*)(lds + OFF_G + lane * 4) = G15;
        asm volatile("s_waitcnt lgkmcnt(0)" ::: "memory");
        if (lane == 0) __hip_atomic_fetch_add((LAS unsigned*)cnt, 1u, __ATOMIC_RELAXED, __HIP_MEMORY_SCOPE_WORKGROUP);
        { const unsigned target = 4u * (gc + 1u); unsigned sp = 0u;
          while (*cnt < target) { __builtin_amdgcn_s_sleep(1); if (++sp > (1u << 22)) break; } }
        asm volatile("" ::: "memory");
        const unsigned vlo = (unsigned)raw.v[0] | ((unsigned)raw.v[1] << 16), vhi = (unsigned)raw.v[2] | ((unsigned)raw.v[3] << 16);
        const int crow = row;
        row += 16 * step;
        if (c + 1 < nch) CS_LOAD(row);
        asm volatile("" ::: "memory");
        bf16x8 fKK[2], fR[2], fB[2], fKD[2], fS[2];
#pragma unroll
        for (int s = 0; s < 2; ++s) { fKK[s] = frag_tm(lds, OFF_KK, s, c16, g); fR[s] = frag_tm(lds, OFF_R, s, c16, g); fB[s] = frag_tm(lds, OFF_B, s, c16, g); fKD[s] = frag_tm(lds, OFF_KD, s, c16, g);
            fS[s] = mk8u(cvtpk(ST[2 * s][0], ST[2 * s][1]), cvtpk(ST[2 * s][2], ST[2 * s][3]), cvtpk(ST[2 * s + 1][0], ST[2 * s + 1][1]), cvtpk(ST[2 * s + 1][2], ST[2 * s + 1][3])); }
        const f32x4 z4 = {0.f, 0.f, 0.f, 0.f};
        f32x4 P = z4, Y = z4, Ab = z4, AbT = z4, AdT = z4, RbT = z4, RdT = z4;
#pragma unroll
        for (int s = 0; s < 2; ++s) {
            P = __builtin_amdgcn_mfma_f32_16x16x32_bf16(fKK[s], fS[s], P, 0, 0, 0);
            Y = __builtin_amdgcn_mfma_f32_16x16x32_bf16(fR[s], fS[s], Y, 0, 0, 0);
            Ab = __builtin_amdgcn_mfma_f32_16x16x32_bf16(fKK[s], fB[s], Ab, 0, 0, 0);
            AbT = __builtin_amdgcn_mfma_f32_16x16x32_bf16(fB[s], fKK[s], AbT, 0, 0, 0);
            AdT = __builtin_amdgcn_mfma_f32_16x16x32_bf16(fKD[s], fKK[s], AdT, 0, 0, 0);
            RbT = __builtin_amdgcn_mfma_f32_16x16x32_bf16(fB[s], fR[s], RbT, 0, 0, 0);
            RdT = __builtin_amdgcn_mfma_f32_16x16x32_bf16(fKD[s], fR[s], RdT, 0, 0, 0);
        }
        {
            float bx[4];
#pragma unroll
            for (int tt = 0; tt < 4; ++tt) { float x = bterm[tt]; x += dpp_mov<0xB1>(x); x += dpp_mov<0x4E>(x); x += dpp_mov<0x141>(x); x += dpp_mov<0x140>(x); bx[tt] = x; }
            const int l3 = lane & 3; float z = l3 == 0 ? bx[0] : (l3 == 1 ? bx[1] : (l3 == 2 ? bx[2] : bx[3]));
            z = red4rows(z);
            if (lane < 4) bon[(size_t)(crow + (4 * wv + lane) * step) * 16] = z;
        }
        float abn[4];
#pragma unroll
        for (int j = 0; j < 4; ++j) { const int m = 4 * g + j;
            abn[j] = c16 < m ? -Ab[j] : 0.f;
            AdT[j] = m < c16 ? AdT[j] : 0.f;
            AbT[j] = m < c16 ? -AbT[j] : 0.f;
            RbT[j] = m <= c16 ? RbT[j] : 0.f; RdT[j] = m <= c16 ? RdT[j] : 0.f; }
        const f32x4 acc = __builtin_amdgcn_mfma_f32_16x16x32_bf16(mk8u(cvtpk(AdT[0], AdT[1]), cvtpk(AdT[2], AdT[3]), 0u, 0u), mk8u(vlo, vhi, 0u, 0u), P, 0, 0, 0);
        float u[4] = {-acc[0], -acc[1], -acc[2], -acc[3]};
        {
            const unsigned pA0 = cvtpk(AbT[0], AbT[1]), pA1 = cvtpk(AbT[2], AbT[3]);
            BlockSolve<0>::run(u, abn, pA0, pA1, c16, g);
        }
        const bf16x8 UV = mk8u(cvtpk(u[0], u[1]), cvtpk(u[2], u[3]), vlo, vhi);
        Y = __builtin_amdgcn_mfma_f32_16x16x32_bf16(mk8u(cvtpk(RbT[0], RbT[1]), cvtpk(RbT[2], RbT[3]), cvtpk(RdT[0], RdT[1]), cvtpk(RdT[2], RdT[3])), UV, Y, 0, 0, 0);
#pragma unroll
        for (int tl = 0; tl < 4; ++tl) {
            const f32x4 gv = *(const f32x4*)(lds + OFF_G + (16 * tl + 4 * g) * 4);
            const int kr_ = 16 * tl + c16;
            const bf16x8 fa = mk8(*(const u32x2*)(lds + OFF_BT + kr_ * 32 + g * 8), *(const u32x2*)(lds + OFF_KDT + kr_ * 32 + g * 8));
            ST[tl] = __builtin_amdgcn_mfma_f32_16x16x32_bf16(fa, UV, ST[tl] * gv, 0, 0, 0);
        }
#pragma unroll
        for (int j = 0; j < 4; ++j) yb[(size_t)(crow + (4 * g + j) * step) * 1024 + h * 64 + v0 + c16] = f2bf(Y[j]);
        asm volatile("" ::: "memory");
    }
#undef CS_LOAD
    if (s_out) {
#pragma unroll
        for (int tl = 0; tl < 4; ++tl) *(f32x4*)(s_out + (v0 + c16) * 64 + 16 * tl + 4 * g) = ST[tl];
    }
}
}

#define XB_TMO      128
#define XB_XCNT(j)  (256  + 64 * (j))
#define XB_XSUB(j)  (1280 + 64 * (j))
#define XB_XGEN(j)  (2304 + 64 * (j))
#define XB_TOP      3328
#define XB_TOPGEN   3392
#define XCD_BAR_WORDS 3456
#define XB_SPIN_CAP (1u << 22)
__device__ __forceinline__ unsigned xb_ld(unsigned* p)              { return __hip_atomic_load(p, __ATOMIC_RELAXED, __HIP_MEMORY_SCOPE_AGENT); }
__device__ __forceinline__ unsigned xb_add(unsigned* p, unsigned v) { return __hip_atomic_fetch_add(p, v, __ATOMIC_RELAXED, __HIP_MEMORY_SCOPE_AGENT); }
__device__ __forceinline__ unsigned xb_xcc_id() { return (unsigned)__builtin_amdgcn_s_getreg((3 << 11) | 20) & 0xFu; }
#define XB_SPIN(cond, bar) do { unsigned _sp = 0; while (cond) { __builtin_amdgcn_s_sleep(1); \
    if ((++_sp & 255u) == 0u) { if (xb_ld(&(bar)[XB_TMO])) break; if (_sp > XB_SPIN_CAP) { atomicAdd(&(bar)[XB_TMO], 1u); break; } } } } while (0)
struct XcdBarrier { unsigned* bar; unsigned x; volatile LAS unsigned* st; };
__device__ __forceinline__ XcdBarrier xcd_barrier_post(unsigned* bar, volatile LAS unsigned* st) {
    XcdBarrier b; b.bar = bar; b.x = xb_xcc_id(); b.st = st;
    if (threadIdx.x == 0) (void)xb_add(&bar[XB_XCNT(b.x)], 1u);
    return b;
}
__device__ __forceinline__ void xcd_barrier_complete(unsigned* bar, unsigned x, unsigned& nloc, unsigned& nx) {
    const unsigned G = gridDim.x * gridDim.y * gridDim.z;
    unsigned sum, cnt, mine, sp = 0u;
    for (;;) {
        sum = 0u; cnt = 0u; mine = 0u;
#pragma unroll
        for (unsigned j = 0; j < 16; ++j) { const unsigned c = xb_ld(&bar[XB_XCNT(j)]); sum += c; cnt += (c > 0u) ? 1u : 0u; mine = (j == x) ? c : mine; }
        if (sum == G) break;
        __builtin_amdgcn_s_sleep(1);
        if ((++sp & 255u) == 0u) { if (xb_ld(&bar[XB_TMO])) break; if (sp > XB_SPIN_CAP) { atomicAdd(&bar[XB_TMO], 1u); break; } }
    }
    nloc = mine > 0u ? mine : 1u; nx = cnt > 0u ? cnt : 1u;
}
__device__ __forceinline__ void xcd_barrier(const XcdBarrier& b) {
    asm volatile("s_waitcnt vmcnt(0)" ::: "memory");
    __syncthreads();
    if (threadIdx.x == 0) {
        unsigned* bar = b.bar;
        __builtin_amdgcn_s_waitcnt(0);
        unsigned nloc = b.st[0], nx = b.st[1];
        if (nloc == 0u) { xcd_barrier_complete(bar, b.x, nloc, nx); b.st[0] = nloc; b.st[1] = nx; }
        const unsigned old = xb_add(&bar[XB_XSUB(b.x)], 1u);
        const unsigned gen = old / nloc;
        if (old + 1u == (gen + 1u) * nloc) {
            __builtin_amdgcn_fence(__ATOMIC_RELEASE, "agent");
            asm volatile("s_waitcnt vmcnt(0)" ::: "memory");
            const unsigned og = xb_add(&bar[XB_TOP], 1u);
            const unsigned tg = og / nx;
            if (og + 1u == (tg + 1u) * nx) xb_add(&bar[XB_TOPGEN], 1u);
            else XB_SPIN(xb_ld(&bar[XB_TOPGEN]) == tg, bar);
            __builtin_amdgcn_fence(__ATOMIC_ACQUIRE, "agent");
            xb_add(&bar[XB_XGEN(b.x)], 1u);
            asm volatile("s_waitcnt vmcnt(0)" ::: "memory");
        } else {
            XB_SPIN(xb_ld(&bar[XB_XGEN(b.x)]) == gen, bar);
            __builtin_amdgcn_fence(__ATOMIC_ACQUIRE, "agent");
            asm volatile("s_waitcnt vmcnt(0)" ::: "memory");
        }
    }
    __syncthreads();
}

__device__ __forceinline__ float wave_sum(float v) {
#pragma unroll
    for (int m = 32; m >= 1; m >>= 1) v += __shfl_xor(v, m);
    return v;
}

__global__ __launch_bounds__(512, 2) void mega(Params p) {
    extern __shared__ __attribute__((aligned(16))) unsigned char shm[];
    LAS unsigned char* lds = (LAS unsigned char*)shm;
    __shared__ uint4 xb_words;
    cg::grid_group grid = cg::this_grid();
    const int tid = threadIdx.x, wid = __builtin_amdgcn_readfirstlane(tid >> 6), lane = tid & 63, G = gridDim.x, bid = blockIdx.x;
    char* ws = p.ws;
    if (tid == 0) xb_words = make_uint4(0u, 0u, 0u, 0u);
    __syncthreads();
    const XcdBarrier xbar = xcd_barrier_post((unsigned*)(ws + O_BAR), (volatile LAS unsigned*)&xb_words);
    if (p.phase_lo < 0) grid.sync();
    float* mod = (float*)(ws + O_MOD);
#ifdef SYNCPROBE
    for (int i_ = 0; i_ < 16; ++i_) xcd_barrier(xbar);
#endif
        for (int rep_ = 0; rep_ < 1 + ((REPM >> 0) & 1); ++rep_) { if (rep_) xcd_barrier(xbar);
        if (((PHM >> 0) & 1) && p.phase_lo <= 0 && 0 < p.phase_hi) {
            float* sl = (float*)shm;
            for (int it = bid; it < 192; it += G) {
                const int kc = it / 6, cb = it % 6, k0 = kc * 64, col = cb * 2048 + tid * 4;
                __syncthreads();
                for (int i = tid; i < 576; i += 512) { const int c = i >> 6, kk = i & 63; const float x = c == 0 ? p.c_ctx[k0 + kk] : p.c[(c - 1) * DM + k0 + kk]; sl[i] = x * sigmoidf_(x); }
                __syncthreads();
                f32x4 acc[9];
#pragma unroll
                for (int c = 0; c < 9; ++c) acc[c] = (f32x4){0.f, 0.f, 0.f, 0.f};
                if (kc == 0) { const f32x4 b = *(const f32x4*)(p.b_mod + col);
#pragma unroll
                    for (int c = 0; c < 9; ++c) acc[c] = b; }
#pragma unroll 8
                for (int kk = 0; kk < 64; ++kk) {
                    const f32x4 w = *(const f32x4*)(p.w_mod + (size_t)(k0 + kk) * 12288 + col);
#pragma unroll
                    for (int c = 0; c < 9; ++c) { const float s = sl[c * 64 + kk]; acc[c] += w * s; }
                }
#pragma unroll
                for (int c = 0; c < 9; ++c)
#pragma unroll
                    for (int j = 0; j < 4; ++j) atomicAdd(mod + c * 12288 + col + j, acc[c][j]);
            }
            {
                float* ct = (float*)(ws + O_ROPE); float* st = ct + 2048 * 32;
                for (int i = bid * 512 + tid; i < 2048 * 32; i += G * 512) {
                    const int pos = i >> 5, f = i & 31; const int gr = pos >> 6, gc = pos & 63;
                    const float fr = powf(10000.f, -(float)(f & 15) / 16.f);
                    const float ang = (float)(f < 16 ? gr : gc) * fr;
                    ct[i] = (float)cos((double)ang); st[i] = (float)sin((double)ang);
                }
            }
            conv_weight((bf16_t*)(ws + O_WIN), INP, 2048, [&](int n, int k) -> float {
                if (n >= INC) return 0.f;
                int c = n; if (n >= 768 && n < 832) { const int q = n - 768; c = 768 + (q & 1) * 32 + (q >> 1); }
                return p.w_in[(size_t)k * INC + c]; });
            conv_weight((bf16_t*)(ws + O_WUQ), 1536, 512, [&](int n, int k) -> float {
                const int hh = n / 192, c = n % 192; int sc = c; if (c >= 128) { const int q = c - 128; sc = 128 + (q & 1) * 32 + (q >> 1); }
                return p.w_uq[(size_t)k * 1536 + hh * 192 + sc]; });
            conv_weight((bf16_t*)(ws + O_WKV), 2048, 256, [&](int n, int k) -> float { return n < 1024 ? p.w_uk[(size_t)k * 1024 + n] : p.w_uv[(size_t)k * 1024 + n - 1024]; });
            conv_weight((bf16_t*)(ws + O_WLO), 5120, 256, [&](int n, int k) -> float {
                const int kind = n >> 10, c = n & 1023;
                if (kind == 0) return k < 64 ? p.w_up_f[(size_t)k * 1024 + c] : 0.f;
                if (kind == 1) return k < 64 ? p.w_up_b[(size_t)k * 1024 + c] : 0.f;
                if (kind == 2) return (k >= 64 && k < 128) ? p.a_up_f[(size_t)(k - 64) * 1024 + c] : 0.f;
                if (kind == 3) return (k >= 64 && k < 128) ? p.a_up_b[(size_t)(k - 64) * 1024 + c] : 0.f;
                return k >= 128 ? p.g_up[(size_t)(k - 128) * 1024 + c] : 0.f; });
            conv_weight((bf16_t*)(ws + O_WOUT), 2048, 2048, [&](int n, int k) -> float { return p.w_out[(size_t)k * 2048 + n]; });
        }
        }
        if (p.phase_lo <= 0 && 0 + 1 < p.phase_hi) xcd_barrier(xbar);
        for (int rep_ = 0; rep_ < 1 + ((REPM >> 1) & 1); ++rep_) { if (rep_) xcd_barrier(xbar);
        if (((PHM >> 1) & 1) && p.phase_lo <= 1 && 1 < p.phase_hi) {
            bf16_t* xm = (bf16_t*)(ws + O_XM);
            const size_t NI = (size_t)T * 256, stride = (size_t)G * 512;
            for (size_t i = (size_t)bid * 512 + tid; i < NI; i += 4 * stride) {
                f32x4 xa[4][2];
#pragma unroll
                for (int u = 0; u < 4; ++u) { const size_t ii = i + u * stride; if (ii < NI) { const int row = (int)(ii >> 8), c0 = (int)(ii & 255) * 8; const float* xr = xrow(p, row) + c0;
                        xa[u][0] = ldntf(xr); xa[u][1] = ldntf(xr + 4); } }
#pragma unroll
                for (int u = 0; u < 4; ++u) { const size_t ii = i + u * stride; if (ii < NI) { const int row = (int)(ii >> 8), c0 = (int)(ii & 255) * 8; const float* m = mod + cond_of(row) * 12288;
                        const f32x4 sc0 = *(const f32x4*)(m + 2048 + c0), sc1 = *(const f32x4*)(m + 2048 + c0 + 4), sh0 = *(const f32x4*)(m + c0), sh1 = *(const f32x4*)(m + c0 + 4);
                        const f32x4 o0 = xa[u][0] * (1.f + sc0) + sh0, o1 = xa[u][1] * (1.f + sc1) + sh1;
                        *(u32x4*)(xm + (size_t)row * 2048 + c0) = (u32x4){cvtpk(o0[0], o0[1]), cvtpk(o0[2], o0[3]), cvtpk(o1[0], o1[1]), cvtpk(o1[2], o1[3])}; } }
            }
        }
        }
        if (p.phase_lo <= 1 && 1 + 1 < p.phase_hi) xcd_barrier(xbar);
        for (int rep_ = 0; rep_ < 1 + ((REPM >> 2) & 1); ++rep_) { if (rep_) xcd_barrier(xbar);
        if (((PHM >> 2) & 1) && p.phase_lo <= 2 && 2 < p.phase_hi) {
            bf16_t* proj = (bf16_t*)(ws + O_PROJ);
            run_gemm(lds, (const bf16_t*)(ws + O_XM), (const bf16_t*)(ws + O_WIN), T, INP, 2048, 0, proj, INC, INC, [=](int, int, f32x4 v) -> f32x4 { return v; });
            {
                const int nun = (T / 256) * (INP / 256), r = nun % G, b0 = r, nb = G - r;
                if (r > 0) conv_weight((bf16_t*)(ws + O_WGU), 11264, 2048, [&](int n, int k) -> float {
                    const int pt = n >> 8, j = n & 255; return j < 128 ? p.w_gate[(size_t)k * DFF + pt * 128 + j] : p.w_up[(size_t)k * DFF + pt * 128 + j - 128]; }, b0, nb);
                else conv_weight((bf16_t*)(ws + O_WGU), 11264, 2048, [&](int n, int k) -> float {
                    const int pt = n >> 8, j = n & 255; return j < 128 ? p.w_gate[(size_t)k * DFF + pt * 128 + j] : p.w_up[(size_t)k * DFF + pt * 128 + j - 128]; });
            }
        }
        }
        if (p.phase_lo <= 2 && 2 + 1 < p.phase_hi) xcd_barrier(xbar);
        for (int rep_ = 0; rep_ < 1 + ((REPM >> 3) & 1); ++rep_) { if (rep_) xcd_barrier(xbar);
        if (((PHM >> 3) & 1) && p.phase_lo <= 3 && 3 < p.phase_hi) {
            const bf16_t* proj = (const bf16_t*)(ws + O_PROJ);
            bf16_t* qn = (bf16_t*)(ws + O_QN); bf16_t* ckv = (bf16_t*)(ws + O_CKV); bf16_t* kr = (bf16_t*)(ws + O_KR); bf16_t* lin = (bf16_t*)(ws + O_LIN);
            bf16_t* rb = (bf16_t*)(ws + O_R); bf16_t* kb = (bf16_t*)(ws + O_K); bf16_t* vb = (bf16_t*)(ws + O_V); float* rkb = (float*)(ws + O_RK);
            const float* ct = (const float*)(ws + O_ROPE); const float* st = ct + 2048 * 32;
            {
                constexpr int R = 4;
                const bool shift = (wid >= 2) || (wid == 1 && lane >= 32);
                const int seg = (wid - 2) >> 1, gi = ((wid - 2) & 1) * 64 + lane;
                const int col = wid == 0 ? lane * 8 : (wid == 1 ? (lane < 32 ? 512 + lane * 8 : 3904 + (lane - 32) * 8) : 832 + seg * 1024 + gi * 8);
                float cw[8];
#pragma unroll
                for (int j = 0; j < 8; ++j) cw[j] = wid == 0 ? p.q_norm_g[col + j] : ((wid == 1 && lane < 32) ? p.kv_norm_g[col - 512 + j] : p.tok_mu[col - 832 + j]);
                float kkc[8];
#pragma unroll
                for (int j = 0; j < 8; ++j) kkc[j] = (wid == 4 || wid == 5) ? p.k_k[gi * 8 + j] : 0.f;
#define P3_LOAD(R0, CQ, PQ, NQ, KQ) do { _Pragma("unroll") for (int rr = 0; rr < R; ++rr) { \
                        const int row_ = (R0) + rr; const bf16_t* pr = proj + (size_t)row_ * INC; \
                        const bool ctx_ = row_ < TP; const int pos_ = ctx_ ? (row_ & 255) : ((row_ - TP) & 2047), len_ = ctx_ ? 256 : 2048; \
                        CQ[rr] = *(const u32x4*)(pr + col); \
                        if (rr == 0) PQ[0] = (shift && pos_ > 0) ? *(const u32x4*)(pr - INC + col) : (u32x4){0u, 0u, 0u, 0u};           \
                        if (rr == R - 1) NQ[0] = (shift && pos_ < len_ - 1) ? *(const u32x4*)(pr + INC + col) : (u32x4){0u, 0u, 0u, 0u}; \
                        KQ[rr] = (wid == 0 && lane < 8) ? *(const u32x4*)(pr + 768 + lane * 8) : (u32x4){0u, 0u, 0u, 0u}; } } while (0)
                u32x4 cq[R], pq[1], nq[1], kq4[R], cq2[R], pq2[1], nq2[1], kq42[R];
                P3_LOAD(bid * R, cq, pq, nq, kq4);
                for (int row0 = bid * R; row0 < T; row0 += G * R) {
                    if (row0 + G * R < T) P3_LOAD(row0 + G * R, cq2, pq2, nq2, kq42);
#pragma unroll
                    for (int rr = 0; rr < R; ++rr) {
                        const int row = row0 + rr;
                        const bool ctx = row < TP; const int pos = ctx ? (row & 255) : ((row - TP) & 2047); const int kvr = kvrow_of(row);
                        float x[8]; unpack8(cq[rr], x);
                        if (shift) { float p8[8], n8[8]; unpack8(rr == 0 ? pq[0] : cq[rr > 0 ? rr - 1 : 0], p8); unpack8(rr == R - 1 ? nq[0] : cq[rr < R - 1 ? rr + 1 : 0], n8);
#pragma unroll
                            for (int j = 0; j < 8; ++j) x[j] = x[j] + cw[j] * (0.5f * (p8[j] + n8[j]) - x[j]); }
                        if (wid == 0) {
                            float ss = 0.f;
#pragma unroll
                            for (int j = 0; j < 8; ++j) ss += x[j] * x[j];
                            ss = wave_sum(ss); const float rs = rsqrtf(ss * (1.f / 512.f) + RMS_EPS);
#pragma unroll
                            for (int j = 0; j < 8; ++j) x[j] = x[j] * rs * cw[j];
                            *(u32x4*)(qn + (size_t)row * 512 + lane * 8) = pack8(x);
                            if (lane < 8) {
                                float kx[8]; unpack8(kq4[rr], kx);
                                if (ctx) {
                                    float* o = p.out + OUT_KR + (size_t)row * 64;
#pragma unroll
                                    for (int j = 0; j < 4; ++j) { o[lane * 4 + j] = kx[2 * j]; o[32 + lane * 4 + j] = kx[2 * j + 1]; }
                                } else {
#pragma unroll
                                    for (int j = 0; j < 4; ++j) { const float cs = ct[pos * 32 + lane * 4 + j], sn = st[pos * 32 + lane * 4 + j]; const float x1 = kx[2 * j], x2 = kx[2 * j + 1];
                                        kx[2 * j] = x1 * cs - x2 * sn; kx[2 * j + 1] = x2 * cs + x1 * sn; }
                                }
                                *(u32x4*)(kr + (size_t)kvr * 64 + lane * 8) = pack8(kx);
                            }
                        } else if (wid == 1) {
                            float ss = 0.f;
#pragma unroll
                            for (int j = 0; j < 8; ++j) ss += x[j] * x[j];
#pragma unroll
                            for (int m = 16; m >= 1; m >>= 1) ss += __shfl_xor(ss, m);
                            if (lane < 32) {
                                const float rs = rsqrtf(ss * (1.f / 256.f) + RMS_EPS);
#pragma unroll
                                for (int j = 0; j < 8; ++j) x[j] = x[j] * rs * cw[j];
                                *(u32x4*)(ckv + (size_t)kvr * 256 + lane * 8) = pack8(x);
                                if (ctx) { float* o = p.out + OUT_CKV + (size_t)row * 256 + lane * 8; *(f32x4*)o = (f32x4){x[0], x[1], x[2], x[3]}; *(f32x4*)(o + 4) = (f32x4){x[4], x[5], x[6], x[7]}; }
                            } else {
                                const int l2 = lane - 32;
                                if (l2 < 8) {
#pragma unroll
                                    for (int j = 0; j < 8; ++j) x[j] = 1.f - 2.f * __builtin_amdgcn_rcpf(1.f + __expf(2.f * x[j]));
                                } else if (l2 >= 16) {
#pragma unroll
                                    for (int j = 0; j < 8; ++j) x[j] = sigmoidf_(x[j]);
                                }
                                *(u32x4*)(lin + (size_t)row * 256 + l2 * 8) = pack8(x);
                            }
                        } else {
                            const int c0 = gi * 8;
                            const u32x4 w = pack8(x);
                            bf16_t* dst = seg == 0 ? rb : (seg == 1 ? kb : vb);
                            *(u32x4*)(dst + (size_t)row * 1024 + c0) = w;
                            if (seg == 1) {
                                float kq[8]; unpack8(w, kq); float ss = 0.f;
#pragma unroll
                                for (int j = 0; j < 8; ++j) { const float t = kq[j] * kkc[j]; ss += t * t; }
                                ss += __shfl_xor(ss, 1); ss += __shfl_xor(ss, 2); ss += __shfl_xor(ss, 4);
                                if ((lane & 7) == 0) rkb[(size_t)row * 16 + (c0 >> 6)] = rsqrtf(fmaxf(ss, 1e-24f));
                            }
                        }
                    }
#pragma unroll
                    for (int rr = 0; rr < R; ++rr) { cq[rr] = cq2[rr]; kq4[rr] = kq42[rr]; }
                    pq[0] = pq2[0]; nq[0] = nq2[0];
                }
#undef P3_LOAD
            }
            for (int i = bid * 512 + tid; i < 2048 * 40; i += G * 512) {
                const int j = i / 40, gq = i % 40, b = j >> 8, ps = j & 255, kvr = TP + b * 2304 + 2048 + ps;
                if (gq < 32) {
                    const float* s = p.cache_ckv + (size_t)j * 256 + gq * 8; float f[8];
#pragma unroll
                    for (int e = 0; e < 8; ++e) f[e] = s[e];
                    *(u32x4*)(ckv + (size_t)kvr * 256 + gq * 8) = pack8(f);
                } else {
                    const int gg = gq - 32; const float* s = p.cache_krope + (size_t)j * 64; float f[8];
#pragma unroll
                    for (int e = 0; e < 4; ++e) { f[2 * e] = s[gg * 4 + e]; f[2 * e + 1] = s[32 + gg * 4 + e]; }
                    *(u32x4*)(kr + (size_t)kvr * 64 + gg * 8) = pack8(f);
                }
            }
        }
        }
        if (p.phase_lo <= 3 && 3 + 1 < p.phase_hi) xcd_barrier(xbar);
        for (int rep_ = 0; rep_ < 1 + ((REPM >> 4) & 1); ++rep_) { if (rep_) xcd_barrier(xbar);
        if (((PHM >> 4) & 1) && p.phase_lo <= 4 && 4 < p.phase_hi) {
            float* dec = p.out; bf16_t* ab = (bf16_t*)(ws + O_A); bf16_t* gb = (bf16_t*)(ws + O_G);
            pg8::Gemm g{(const bf16_t*)(ws + O_LIN), (const bf16_t*)(ws + O_WLO), T, 5120, 256}; pg8::StaticOrder S; S.init(T, 5120, G, bid);
            EpiLora E{dec, ab, gb, p.w0_f, p.w0_b, p.a0_f, p.a0_b};
            pg8::gemm_phase(lds, g, S, E);
        }
        }
        if (p.phase_lo <= 4 && 4 + 1 < p.phase_hi) xcd_barrier(xbar);
        for (int rep_ = 0; rep_ < 1 + ((REPM >> 5) & 1); ++rep_) { if (rep_) xcd_barrier(xbar);
        if (((PHM >> 5) & 1) && p.phase_lo <= 5 && 5 < p.phase_hi) {
            const int wv = wid & 3, grp = wid >> 2; char* gl = (char*)shm + grp * cs::GROUP_LDS;
            volatile LAS unsigned* cnt = (volatile LAS unsigned*)(lds + 2 * cs::GROUP_LDS + grp * 64);
            __syncthreads();
            if (tid == 0) { *(volatile LAS unsigned*)(lds + 2 * cs::GROUP_LDS) = 0u; *(volatile LAS unsigned*)(lds + 2 * cs::GROUP_LDS + 64) = 0u; }
            __syncthreads();
            unsigned gc = 0u;
            if (wid < 4) {
                for (int s = bid; s < 256; s += G) { const int b = s >> 5, h = (s >> 1) & 15, dir = s & 1;
                    cs::scan_chunked(p, gl, cnt, gc, TP + b * 2048, 2048, h, dir, (dir ? p.st_b : p.st_f) + (size_t)(b * 16 + h) * 4096, nullptr, wv, lane); }
            } else {
                for (int s = bid; s < 512; s += G) { const int b = s >> 5, h = (s >> 1) & 15, dir = s & 1;
                    cs::scan_chunked(p, gl, cnt, gc, b * 256, 256, h, dir, nullptr, p.out + (dir ? OUT_SB : OUT_SF) + (size_t)(b * 16 + h) * 4096, wv, lane); }
            }
        }
        }
        if (p.phase_lo <= 5 && 5 + 1 < p.phase_hi) xcd_barrier(xbar);
        for (int rep_ = 0; rep_ < 1 + ((REPM >> 6) & 1); ++rep_) { if (rep_) xcd_barrier(xbar);
        if (((PHM >> 6) & 1) && p.phase_lo <= 6 && 6 < p.phase_hi) {
            const bf16_t* yf = (const bf16_t*)(ws + O_YF); const bf16_t* yb = (const bf16_t*)(ws + O_YB);
            const bf16_t* vb = (const bf16_t*)(ws + O_V); const bf16_t* gb = (const bf16_t*)(ws + O_G);
            const float* bonf = (const float*)(ws + O_BON); const float* bonb = bonf + (size_t)T * 16;
            bf16_t* mix = (bf16_t*)p.out;
            const int c0 = (tid & 127) * 8, hd = c0 >> 6;
            float gg8[8], gb8[8];
#pragma unroll
            for (int j = 0; j < 8; ++j) { gg8[j] = p.gn_g[c0 + j]; gb8[j] = p.gn_b[c0 + j]; }
            const size_t NI = (size_t)T * 128, stride = (size_t)G * 512;
#define P6_LOAD(L_, B_, i_) do { _Pragma("unroll") for (int u = 0; u < 2; ++u) { const size_t ii = (i_) + u * stride; if (ii < NI) { const size_t rw_ = ii >> 7, o = rw_ * 1024 + c0; \
                        L_[u][0] = ldnt(yf + o); L_[u][1] = ldnt(yb + o); L_[u][2] = ldnt(vb + o); L_[u][3] = ldnt(gb + o); B_[u] = bonf[rw_ * 16 + hd] + bonb[rw_ * 16 + hd]; } } } while (0)
            u32x4 L[2][4], Ln[2][4]; float Bs[2], Bn[2];
            size_t i = (size_t)bid * 512 + tid;
            P6_LOAD(L, Bs, i);
            for (; i < NI; i += 2 * stride) {
                if (i + 2 * stride < NI) P6_LOAD(Ln, Bn, i + 2 * stride);
#pragma unroll
                for (int u = 0; u < 2; ++u) { const size_t ii = i + u * stride; if (ii < NI) { const size_t row = ii >> 7;
                    float y[8], t8[8], v8[8], g8[8];
                    unpack8(L[u][0], y); unpack8(L[u][1], t8); unpack8(L[u][2], v8); unpack8(L[u][3], g8);
                    const float sb = Bs[u]; float s1 = 0.f;
#pragma unroll
                    for (int j = 0; j < 8; ++j) { y[j] += t8[j]; s1 += y[j]; }
                    s1 += __shfl_xor(s1, 1); s1 += __shfl_xor(s1, 2); s1 += __shfl_xor(s1, 4);
                    const float mu = s1 * (1.f / 64.f); float s2 = 0.f;
#pragma unroll
                    for (int j = 0; j < 8; ++j) { y[j] -= mu; s2 += y[j] * y[j]; }
                    s2 += __shfl_xor(s2, 1); s2 += __shfl_xor(s2, 2); s2 += __shfl_xor(s2, 4);
                    const float rs = rsqrtf(s2 * (1.f / 64.f) + GN_EPS); float ov[8];
#pragma unroll
                    for (int j = 0; j < 8; ++j) ov[j] = (y[j] * rs * gg8[j] + gb8[j] + sb * v8[j]) * g8[j];
                    *(u32x4*)(mix + row * 2048 + 1024 + c0) = pack8(ov); } }
#pragma unroll
                for (int u = 0; u < 2; ++u) { Bs[u] = Bn[u];
#pragma unroll
                    for (int q = 0; q < 4; ++q) L[u][q] = Ln[u][q]; }
            }
#undef P6_LOAD
        }
        }
        if (p.phase_lo <= 6 && 6 + 1 < p.phase_hi) xcd_barrier(xbar);
        for (int rep_ = 0; rep_ < 1 + ((REPM >> 7) & 1); ++rep_) { if (rep_) xcd_barrier(xbar);
        if (((PHM >> 7) & 1) && p.phase_lo <= 7 && 7 < p.phase_hi) {
            bf16_t* q = (bf16_t*)(ws + O_Q); bf16_t* kvb = (bf16_t*)(ws + O_KVB);
            const float* ct = (const float*)(ws + O_ROPE); const float* st = ct + 2048 * 32;
            run_gemm(lds, (const bf16_t*)(ws + O_QN), (const bf16_t*)(ws + O_WUQ), T, 1536, 512, 0, q, 1536, 1536, [=](int row, int col, f32x4 v) -> f32x4 {
                const int c = col % 192;
                if (c >= 128 && row >= TP) { const int pos = (row - TP) & 2047, i = (c - 128) >> 1;
                    const float c0 = ct[pos * 32 + i], s0 = st[pos * 32 + i], c1 = ct[pos * 32 + i + 1], s1 = st[pos * 32 + i + 1];
                    const f32x4 t = v; v[0] = t[0] * c0 - t[1] * s0; v[1] = t[1] * c0 + t[0] * s0; v[2] = t[2] * c1 - t[3] * s1; v[3] = t[3] * c1 + t[2] * s1; }
                return v; });
            run_gemm(lds, (const bf16_t*)(ws + O_CKV), (const bf16_t*)(ws + O_WKV), KVROWS, 2048, 256, 224, kvb, 2048, 2048, [=](int, int, f32x4 v) -> f32x4 { return v; });
        }
        }
        if (p.phase_lo <= 7 && 7 + 1 < p.phase_hi) xcd_barrier(xbar);
        for (int rep_ = 0; rep_ < 1 + ((REPM >> 8) & 1); ++rep_) { if (rep_) xcd_barrier(xbar);
        if (((PHM >> 8) & 1) && p.phase_lo <= 8 && 8 < p.phase_hi) {
            const bf16_t* q = (const bf16_t*)(ws + O_Q); const bf16_t* kvb = (const bf16_t*)(ws + O_KVB); const bf16_t* kr = (const bf16_t*)(ws + O_KR);
            bf16_t* mix = (bf16_t*)p.out;
            const int xcd = bid & 7, slot = bid >> 3;
            for (int j = 0; ; ++j) {
                const int bh = j * (G >> 3) + xcd * (G >> 6) + (slot >> 3); if (bh >= 64 || (G >> 6) == 0) break;
                const int b = bh >> 3, h = bh & 7, qb = slot & 7; const size_t qrow = TP + (size_t)b * 2048 + qb * 256, kvr = TP + (size_t)b * 2304;
                att::attn_body(q + qrow * 1536 + h * 192, kvb + kvr * 2048 + h * 128, kvb + kvr * 2048 + 1024 + h * 128, kr + kvr * 64, mix + qrow * 2048 + h * 128, 2304, (char*)shm);
            }
            for (int it = bid; it < 128; it += G) {
                const int b = it >> 3, h = it & 7; const size_t qrow = (size_t)b * 256;
                att::attn_body(q + qrow * 1536 + h * 192, kvb + qrow * 2048 + h * 128, kvb + qrow * 2048 + 1024 + h * 128, kr + qrow * 64, mix + qrow * 2048 + h * 128, 256, (char*)shm);
            }
        }
        }
        if (p.phase_lo <= 8 && 8 + 1 < p.phase_hi) xcd_barrier(xbar);
        for (int rep_ = 0; rep_ < 1 + ((REPM >> 9) & 1); ++rep_) { if (rep_) xcd_barrier(xbar);
        if (((PHM >> 9) & 1) && p.phase_lo <= 9 && 9 < p.phase_hi) {
            bf16_t* h1 = (bf16_t*)(ws + O_H1); const Params* pp = &p; const float* md = mod;
            run_gemm(lds, (const bf16_t*)p.out, (const bf16_t*)(ws + O_WOUT), T, 2048, 2048, 0, h1, 2048, 2048, [=](int row, int col, f32x4 v) -> f32x4 {
                const f32x4 x = *(const f32x4*)(xrow(*pp, row) + col); const f32x4 g1 = *(const f32x4*)(md + cond_of(row) * 12288 + 4096 + col);
                return ALPHA * x + g1 * v; });
            {
                const int b0 = (640 - 2 * G > 0 && 640 - 2 * G < G) ? 640 - 2 * G : 0, nb = G - b0;
                conv_weight((bf16_t*)(ws + O_WDN), 2048, DFF, [&](int n, int k) -> float { return p.w_down[(size_t)k * 2048 + n]; }, b0, nb);
            }
        }
        }
        if (p.phase_lo <= 9 && 9 + 1 < p.phase_hi) xcd_barrier(xbar);
        for (int rep_ = 0; rep_ < 1 + ((REPM >> 10) & 1); ++rep_) { if (rep_) xcd_barrier(xbar);
        if (((PHM >> 10) & 1) && p.phase_lo <= 10 && 10 < p.phase_hi) {
            const bf16_t* h1 = (const bf16_t*)(ws + O_H1); bf16_t* hm = (bf16_t*)(ws + O_XM); bf16_t* x1b = (bf16_t*)p.out;
#define LNC(j) (((j) >> 1) * 512 + lane * 8 + ((j) & 1) * 4)
#define LDBF8(dst, q, ptr) do { const u32x4 w_ = *(const u32x4*)(ptr); \
                dst[2 * (q)] = (f32x4){__uint_as_float(w_[0] << 16), __uint_as_float(w_[0] & 0xffff0000u), __uint_as_float(w_[1] << 16), __uint_as_float(w_[1] & 0xffff0000u)}; \
                dst[2 * (q) + 1] = (f32x4){__uint_as_float(w_[2] << 16), __uint_as_float(w_[2] & 0xffff0000u), __uint_as_float(w_[3] << 16), __uint_as_float(w_[3] & 0xffff0000u)}; } while (0)
            f32x4 lg[8], lb[8];
#pragma unroll
            for (int j = 0; j < 8; ++j) { lg[j] = *(const f32x4*)(p.ln1_g + LNC(j)); lb[j] = *(const f32x4*)(p.ln1_b + LNC(j)); }
            int row = bid * 8 + wid; f32x4 x[8], xn[8];
#pragma unroll
            for (int q = 0; q < 4; ++q) LDBF8(x, q, h1 + (size_t)row * 2048 + q * 512 + lane * 8);
            for (; row < T; row += G * 8) {
                const int nrow = row + G * 8;
                if (nrow < T) {
#pragma unroll
                    for (int q = 0; q < 4; ++q) LDBF8(xn, q, h1 + (size_t)nrow * 2048 + q * 512 + lane * 8); }
                float s = 0.f;
#pragma unroll
                for (int j = 0; j < 8; ++j) s += (x[j][0] + x[j][1]) + (x[j][2] + x[j][3]);
                const float mu = wave_sum(s) * (1.f / 2048.f); float s2 = 0.f;
#pragma unroll
                for (int j = 0; j < 8; ++j) { x[j] -= mu; s2 += (x[j][0] * x[j][0] + x[j][1] * x[j][1]) + (x[j][2] * x[j][2] + x[j][3] * x[j][3]); }
                const float rs = rsqrtf(wave_sum(s2) * (1.f / 2048.f) + LN_EPS); const float* m = mod + cond_of(row) * 12288;
#pragma unroll
                for (int q = 0; q < 4; ++q) { const int c = q * 512 + lane * 8;
                    const f32x4 y0 = x[2 * q] * rs * lg[2 * q] + lb[2 * q], y1 = x[2 * q + 1] * rs * lg[2 * q + 1] + lb[2 * q + 1];
                    *(u32x4*)(x1b + (size_t)row * 2048 + c) = (u32x4){cvtpk(y0[0], y0[1]), cvtpk(y0[2], y0[3]), cvtpk(y1[0], y1[1]), cvtpk(y1[2], y1[3])};
                    const f32x4 z0 = y0 * (1.f + *(const f32x4*)(m + 4 * 2048 + c)) + *(const f32x4*)(m + 3 * 2048 + c);
                    const f32x4 z1 = y1 * (1.f + *(const f32x4*)(m + 4 * 2048 + c + 4)) + *(const f32x4*)(m + 3 * 2048 + c + 4);
                    *(u32x4*)(hm + (size_t)row * 2048 + c) = (u32x4){cvtpk(z0[0], z0[1]), cvtpk(z0[2], z0[3]), cvtpk(z1[0], z1[1]), cvtpk(z1[2], z1[3])}; }
#pragma unroll
                for (int j = 0; j < 8; ++j) x[j] = xn[j];
            }
        }
        }
        if (p.phase_lo <= 10 && 10 + 1 < p.phase_hi) xcd_barrier(xbar);
        for (int rep_ = 0; rep_ < 1 + ((REPM >> 11) & 1); ++rep_) { if (rep_) xcd_barrier(xbar);
        if (((PHM >> 11) & 1) && p.phase_lo <= 11 && 11 < p.phase_hi) {
            pg8::Gemm g{(const bf16_t*)(ws + O_XM), (const bf16_t*)(ws + O_WGU), T, 11264, 2048}; pg8::StaticOrder S; S.init(T, 11264, G, bid);
            pg8::EpiSwiglu E{(bf16_t*)(ws + O_ACT)};
            pg8::gemm_phase(lds, g, S, E);
        }
        }
        if (p.phase_lo <= 11 && 11 + 1 < p.phase_hi) xcd_barrier(xbar);
        for (int rep_ = 0; rep_ < 1 + ((REPM >> 12) & 1); ++rep_) { if (rep_) xcd_barrier(xbar);
        if (((PHM >> 12) & 1) && p.phase_lo <= 12 && 12 < p.phase_hi) {
            pg8::Gemm g{(const bf16_t*)(ws + O_ACT), (const bf16_t*)(ws + O_WDN), T, 2048, DFF, 8}; pg8::StaticOrder S; S.init(T, 2048, G, bid);
            { const int r = S.nwg % G; if (r > 0 && 2 * r <= G) S.split_from = S.nwg - r; }
            EpiDown E{(const bf16_t*)p.out, (bf16_t*)(ws + O_XM), (bf16_t*)(ws + O_PART), mod, S.split_from < S.nwg ? S.split_from : S.nwg};
            pg8::gemm_phase(lds, g, S, E);
        }
        }
        if (p.phase_lo <= 12 && 12 + 1 < p.phase_hi) xcd_barrier(xbar);
        for (int rep_ = 0; rep_ < 1 + ((REPM >> 13) & 1); ++rep_) { if (rep_) xcd_barrier(xbar);
        if (((PHM >> 13) & 1) && p.phase_lo <= 13 && 13 < p.phase_hi) {
            f32x4 lg[8], lb[8];
#pragma unroll
            for (int j = 0; j < 8; ++j) { lg[j] = *(const f32x4*)(p.ln2_g + LNC(j)); lb[j] = *(const f32x4*)(p.ln2_b + LNC(j)); }
            int row = bid * 8 + wid; f32x4 x[8], xn[8]; const bf16_t* h2 = (const bf16_t*)(ws + O_XM);
            const bf16_t* part = (const bf16_t*)(ws + O_PART); const int sfrom = (640 % G > 0 && 2 * (640 % G) <= G) ? 640 - 640 % G : 640;
#define P13_LD(dst, r_) do { _Pragma("unroll") for (int q = 0; q < 4; ++q) { const int col_ = q * 512 + lane * 8; LDBF8(dst, q, h2 + (size_t)(r_) * 2048 + col_); \
                const int ui_ = down_unit_index((r_) >> 8, col_ >> 8); \
                if (ui_ >= sfrom) { float pf[8]; unpack8(*(const u32x4*)(part + (size_t)(ui_ - sfrom) * 65536 + ((r_) & 255) * 256 + (col_ & 255)), pf); \
                    dst[2 * q] += (f32x4){pf[0], pf[1], pf[2], pf[3]}; dst[2 * q + 1] += (f32x4){pf[4], pf[5], pf[6], pf[7]}; } } } while (0)
            P13_LD(x, row);
            for (; row < T; row += G * 8) {
                const int nrow = row + G * 8;
                if (nrow < T) P13_LD(xn, nrow);
                float* hr = p.out + (size_t)row * 2048; float s = 0.f;
#pragma unroll
                for (int j = 0; j < 8; ++j) s += (x[j][0] + x[j][1]) + (x[j][2] + x[j][3]);
                const float mu = wave_sum(s) * (1.f / 2048.f); float s2 = 0.f;
#pragma unroll
                for (int j = 0; j < 8; ++j) { x[j] -= mu; s2 += (x[j][0] * x[j][0] + x[j][1] * x[j][1]) + (x[j][2] * x[j][2] + x[j][3] * x[j][3]); }
                const float rs = rsqrtf(wave_sum(s2) * (1.f / 2048.f) + LN_EPS);
#pragma unroll
                for (int j = 0; j < 8; ++j) stntf(hr + LNC(j), x[j] * rs * lg[j] + lb[j]);
#pragma unroll
                for (int j = 0; j < 8; ++j) x[j] = xn[j];
            }
        }
        }
        if (p.phase_lo <= 13 && 13 + 1 < p.phase_hi) xcd_barrier(xbar);
}

extern "C" void kernel_launch(void* const* d_in, const int* in_sizes, int n_in, void* d_out, int out_size, void* d_ws, size_t ws_size, hipStream_t stream) {
    constexpr size_t kDynLds = 131072;
    static int grid_blocks = 0;
    if (!grid_blocks) {
        if (ws_size < WS_END) { fprintf(stderr, "kernel_launch: workspace too small: %zu < %zu\n", ws_size, (size_t)WS_END); return; }
        if (hipFuncSetAttribute((const void*)mega, hipFuncAttributeMaxDynamicSharedMemorySize, (int)kDynLds) != hipSuccess) { fprintf(stderr, "kernel_launch: LDS attribute failed\n"); return; }
        int dev = 0, cus = 0, per_cu = 0;
        hipGetDevice(&dev);
        hipDeviceGetAttribute(&cus, hipDeviceAttributeMultiprocessorCount, dev);
        hipOccupancyMaxActiveBlocksPerMultiprocessor(&per_cu, mega, 512, kDynLds);
        if (per_cu < 1) { fprintf(stderr, "kernel_launch: occupancy 0\n"); return; }
        grid_blocks = cus;
    }
    Params p{};
    const float* const* in = (const float* const*)d_in;
    p.x_prompt = in[0]; p.x_sample = in[1]; p.cache_ckv = in[2]; p.cache_krope = in[3]; p.st_f = in[4]; p.st_b = in[5]; p.c = in[6]; p.c_ctx = in[7];
    p.w_mod = in[8]; p.b_mod = in[9]; p.w_in = in[10]; p.q_norm_g = in[11]; p.kv_norm_g = in[12]; p.w_uq = in[13]; p.w_uk = in[14]; p.w_uv = in[15];
    p.tok_mu = in[16]; p.w0_f = in[17]; p.w_up_f = in[18]; p.a0_f = in[19]; p.a_up_f = in[20]; p.w0_b = in[21]; p.w_up_b = in[22]; p.a0_b = in[23]; p.a_up_b = in[24];
    p.g_up = in[25]; p.k_k = in[26]; p.k_a = in[27]; p.r_k = in[28]; p.gn_g = in[29]; p.gn_b = in[30]; p.w_out = in[31]; p.ln1_g = in[32]; p.ln1_b = in[33];
    p.w_gate = in[34]; p.w_up = in[35]; p.w_down = in[36]; p.ln2_g = in[37]; p.ln2_b = in[38];
    p.out = (float*)d_out; p.ws = (char*)d_ws; p.phase_lo = 0; p.phase_hi = 14;
    hipMemsetAsync((char*)d_ws + O_MOD, 0, (size_t)(O_RK - O_MOD), stream);
    void* args[] = {&p};
    hipError_t e = hipLaunchCooperativeKernel((void*)mega, dim3(grid_blocks), dim3(512), args, kDynLds, stream);
    if (e != hipSuccess) fprintf(stderr, "cooperative launch failed: %s (grid %d)\n", hipGetErrorString(e), grid_blocks);
}
```
